# Optimizing an MI355X kernel written in HIP

```python
import math
import jax, jax.numpy as jnp
from jax import lax
import numpy as np

D_MODEL = 1024
BATCH = 1
SEQ = 16384
DEPTH = 4

N_MIXERS = 4
RMS_EPS = 1e-6
D_FF = ((8 * D_MODEL // 3 + 255) // 256) * 256
DA_HEAD_DIM = 64
DA_HEADS = D_MODEL // (2 * DA_HEAD_DIM)
DA_QBLOCK = 128
RT_HEADS = 4
RT_KEY_DIM = D_MODEL // RT_HEADS
RT_VAL_DIM = 2 * RT_KEY_DIM
RT_CHUNK = 128
SG_WIDTH = 3 * D_MODEL
SG_GROUPS = 8
SG_CHUNK = 128
LRU_WIDTH = ((4 * D_MODEL // 3 + 255) // 256) * 256
LRU_BLOCK = 128
LRU_BLOCKS = LRU_WIDTH // LRU_BLOCK
CONV_WIDTH = 4
RG_C = 8.0

kernel_name = "hybrid_interleaved_macaron_trunk"


def _rms(x, gain):
    x32 = x.astype(jnp.float32)
    y = x32 * lax.rsqrt(jnp.mean(x32 * x32, axis=-1, keepdims=True) + RMS_EPS)
    return (y * gain.astype(jnp.float32)).astype(x.dtype)


def _swiglu(xn, w_in, w_out):
    a, b = jnp.split(xn @ w_in, 2, axis=-1)
    return (jax.nn.silu(a) * b) @ w_out


def _lambda_init(layer_idx):
    return 0.8 - 0.6 * math.exp(-0.3 * layer_idx)


def _diff_attention(xn, w_in, q_gain, k_gain, lam, subln, w_out, lam_init):
    B, T, _ = xn.shape
    H, Dh = DA_HEADS, DA_HEAD_DIM
    q, k, v = jnp.split(xn @ w_in, 3, axis=-1)
    q = _rms(q.reshape(B, T, H, 2, Dh), q_gain) * (Dh ** -0.5)
    k = _rms(k.reshape(B, T, H, 2, Dh), k_gain)
    q = q.transpose(0, 2, 3, 1, 4)
    k = k.transpose(0, 2, 3, 1, 4)
    v = v.reshape(B, T, H, 2 * Dh).transpose(0, 2, 1, 3)
    lam32 = lam.astype(jnp.float32)
    lmbda = (jnp.exp(jnp.sum(lam32[0] * lam32[1])) - jnp.exp(jnp.sum(lam32[2] * lam32[3]))
             + lam_init)
    slopes = 2.0 ** (-8.0 * jnp.arange(1, H + 1, dtype=jnp.float32) / H)
    nb = T // DA_QBLOCK
    q_blocks = q.reshape(B, H, 2, nb, DA_QBLOCK, Dh).transpose(3, 0, 1, 2, 4, 5)
    key_pos = jnp.arange(T)

    def block(args):
        qb, n = args
        q_pos = n * DA_QBLOCK + jnp.arange(DA_QBLOCK)
        s = jnp.einsum('bhmqd,bhmkd->bhmqk', qb, k, preferred_element_type=jnp.float32)
        dist = (q_pos[:, None] - key_pos[None, :]).astype(jnp.float32)
        bias = jnp.where(dist >= 0, -slopes[:, None, None] * dist, -jnp.inf)
        p = jax.nn.softmax(s + bias[None, :, None], axis=-1)
        a = p[:, :, 0] - lmbda * p[:, :, 1]
        return jnp.einsum('bhqk,bhkd->bhqd', a.astype(v.dtype), v)

    o = lax.map(block, (q_blocks, jnp.arange(nb)))
    o = o.transpose(1, 0, 3, 2, 4).reshape(B, T, H, 2 * Dh)
    o = _rms(o, subln) * (1.0 - lam_init)
    return o.reshape(B, T, H * 2 * Dh).astype(xn.dtype) @ w_out


def _retention(xn, w_in, subln, w_out):
    B, T, _ = xn.shape
    H, Dk, Dv, C = RT_HEADS, RT_KEY_DIM, RT_VAL_DIM, RT_CHUNK
    nc = T // C
    proj = xn @ w_in
    q, k, v, g = jnp.split(proj, [H * Dk, 2 * H * Dk, 2 * H * Dk + H * Dv], axis=-1)

    def to_chunks(t, d):
        t = t.astype(jnp.float32).reshape(B, T, H, d).transpose(0, 2, 1, 3)
        return t.reshape(B, H, nc, C, d).transpose(2, 0, 1, 3, 4)

    qc = to_chunks(q, Dk)
    kc = to_chunks(k, Dk) * (Dk ** -0.5)
    vc = to_chunks(v, Dv)
    gamma = 1.0 - 2.0 ** (-5.0 - jnp.arange(H, dtype=jnp.float32))
    log_g = jnp.log(gamma)
    idx = jnp.arange(C, dtype=jnp.float32)
    diff = idx[:, None] - idx[None, :]
    decay_intra = jnp.where(diff >= 0, jnp.exp(jnp.maximum(diff, 0.0) * log_g[:, None, None]), 0.0)
    xi = jnp.exp((idx + 1.0) * log_g[:, None])
    zeta = jnp.exp((C - 1.0 - idx) * log_g[:, None])
    g_chunk = jnp.exp(C * log_g)

    def step(R, inp):
        qq, kk, vv = inp
        att = jnp.einsum('bhqd,bhkd->bhqk', qq, kk) * decay_intra
        o = (jnp.einsum('bhqk,bhkv->bhqv', att, vv)
             + jnp.einsum('bhqd,bhdv->bhqv', qq, R) * xi[:, :, None])
        R = g_chunk[:, None, None] * R + jnp.einsum('bhkd,bhkv->bhdv', kk * zeta[:, :, None], vv)
        return R, o

    R0 = jnp.zeros((B, H, Dk, Dv), jnp.float32)
    _, o = lax.scan(step, R0, (qc, kc, vc))
    o = o.transpose(1, 0, 3, 2, 4).reshape(B, T, H, Dv)
    o = _rms(o, subln).reshape(B, T, H * Dv)
    return (jax.nn.silu(g.astype(jnp.float32)) * o).astype(xn.dtype) @ w_out


def _spatial_gating(xn, w_in, v_gain, w_s, b_s, w_out):
    B, T, _ = xn.shape
    C, G = SG_CHUNK, SG_GROUPS
    nc = T // C
    z = jax.nn.gelu(xn @ w_in)
    u, v = jnp.split(z, 2, axis=-1)
    v = _rms(v, v_gain).reshape(B, nc, C, G, SG_WIDTH // G)
    ws = w_s * jnp.tril(jnp.ones((C, C), w_s.dtype))
    mixed = jnp.einsum('gts,bnsgc->bntgc', ws, v) + jnp.transpose(b_s)[None, None, :, :, None]
    return (u * mixed.reshape(B, T, SG_WIDTH)) @ w_out


def _rglru_block(xn, w_in, conv_w, conv_b, w_a, b_a, w_x, b_x, lam, w_out):
    B, T, _ = xn.shape
    gate_br, xb = jnp.split(xn @ w_in, 2, axis=-1)
    gate = jax.nn.gelu(gate_br)
    xb = lax.conv_general_dilated(
        xb, conv_w[:, None, :].astype(xb.dtype), window_strides=(1,),
        padding=[(CONV_WIDTH - 1, 0)], dimension_numbers=('NWC', 'WIO', 'NWC'),
        feature_group_count=LRU_WIDTH) + conv_b
    xb = xb.astype(jnp.float32)
    xblk = xb.reshape(B, T, LRU_BLOCKS, LRU_BLOCK)
    r = jax.nn.sigmoid(jnp.einsum('btnc,ncd->btnd', xblk, w_a.astype(jnp.float32))
                       .reshape(B, T, LRU_WIDTH) + b_a)
    i = jax.nn.sigmoid(jnp.einsum('btnc,ncd->btnd', xblk, w_x.astype(jnp.float32))
                       .reshape(B, T, LRU_WIDTH) + b_x)
    log_a = -RG_C * r * jax.nn.softplus(-lam.astype(jnp.float32))
    a = jnp.exp(log_a)
    b = jnp.sqrt(jnp.maximum(-jnp.expm1(2.0 * log_a), 1e-12)) * (i * xb)

    def combine(c1, c2):
        a1, b1 = c1
        a2, b2 = c2
        return a1 * a2, a2 * b1 + b2

    _, h = lax.associative_scan(combine, (a, b), axis=1)
    return (h * gate.astype(jnp.float32)).astype(xn.dtype) @ w_out


def setup_inputs(seed: int = 0) -> dict:
    key = jax.random.key(seed)
    keys = iter(jax.random.split(key, 40))
    f32 = jnp.float32

    def nrm(shape, scale):
        return scale * jax.random.normal(next(keys), shape, f32)

    def gain(shape):
        return 1.0 + 0.02 * jax.random.normal(next(keys), shape, f32)

    na, nr, ns, nl = [len(range(m, DEPTH, N_MIXERS)) for m in range(N_MIXERS)]
    D = D_MODEL
    da_width = DA_HEADS * 2 * DA_HEAD_DIM
    rt_in = 2 * RT_HEADS * RT_KEY_DIM + 2 * RT_HEADS * RT_VAL_DIM
    inp = {}
    inp['x'] = jax.random.normal(next(keys), (BATCH, SEQ, D), f32)
    inp['ffn1_norm'] = gain((DEPTH, D))
    inp['ffn1_w_in'] = nrm((DEPTH, D, 2 * D_FF), D ** -0.5)
    inp['ffn1_w_out'] = nrm((DEPTH, D_FF, D), D_FF ** -0.5)
    inp['mix_norm'] = gain((DEPTH, D))
    inp['ffn2_norm'] = gain((DEPTH, D))
    inp['ffn2_w_in'] = nrm((DEPTH, D, 2 * D_FF), D ** -0.5)
    inp['ffn2_w_out'] = nrm((DEPTH, D_FF, D), D_FF ** -0.5)
    inp['da_w_in'] = nrm((na, D, 3 * da_width), D ** -0.5)
    inp['da_q_gain'] = gain((na, DA_HEAD_DIM))
    inp['da_k_gain'] = gain((na, DA_HEAD_DIM))
    inp['da_lambda'] = nrm((na, 4, DA_HEAD_DIM), 0.1)
    inp['da_subln'] = gain((na, 2 * DA_HEAD_DIM))
    inp['da_w_out'] = nrm((na, da_width, D), da_width ** -0.5)
    inp['rt_w_in'] = nrm((nr, D, rt_in), D ** -0.5)
    inp['rt_subln'] = gain((nr, RT_HEADS, RT_VAL_DIM))
    inp['rt_w_out'] = nrm((nr, RT_HEADS * RT_VAL_DIM, D), (RT_HEADS * RT_VAL_DIM) ** -0.5)
    inp['sg_w_in'] = nrm((ns, D, 2 * SG_WIDTH), D ** -0.5)
    inp['sg_v_gain'] = gain((ns, SG_WIDTH))
    inp['sg_w_s'] = nrm((ns, SG_GROUPS, SG_CHUNK, SG_CHUNK), SG_CHUNK ** -0.5)
    inp['sg_b_s'] = 1.0 + nrm((ns, SG_GROUPS, SG_CHUNK), 0.1)
    inp['sg_w_out'] = nrm((ns, SG_WIDTH, D), SG_WIDTH ** -0.5)
    inp['lr_w_in'] = nrm((nl, D, 2 * LRU_WIDTH), D ** -0.5)
    inp['lr_conv_w'] = nrm((nl, CONV_WIDTH, LRU_WIDTH), CONV_WIDTH ** -0.5)
    inp['lr_conv_b'] = nrm((nl, LRU_WIDTH), 0.01)
    inp['lr_w_a'] = nrm((nl, LRU_BLOCKS, LRU_BLOCK, LRU_BLOCK), LRU_BLOCK ** -0.5)
    inp['lr_b_a'] = nrm((nl, LRU_WIDTH), 0.01)
    inp['lr_w_x'] = nrm((nl, LRU_BLOCKS, LRU_BLOCK, LRU_BLOCK), LRU_BLOCK ** -0.5)
    inp['lr_b_x'] = nrm((nl, LRU_WIDTH), 0.01)
    a0 = jax.random.uniform(next(keys), (nl, LRU_WIDTH), f32, 0.9, 0.999)
    s = a0 ** (1.0 / RG_C)
    inp['lr_lambda'] = jnp.log(s) - jnp.log1p(-s)
    inp['lr_w_out'] = nrm((nl, LRU_WIDTH, D), LRU_WIDTH ** -0.5)
    return inp


def reference(x, ffn1_norm, ffn1_w_in, ffn1_w_out, mix_norm, ffn2_norm, ffn2_w_in, ffn2_w_out,
              da_w_in, da_q_gain, da_k_gain, da_lambda, da_subln, da_w_out,
              rt_w_in, rt_subln, rt_w_out,
              sg_w_in, sg_v_gain, sg_w_s, sg_b_s, sg_w_out,
              lr_w_in, lr_conv_w, lr_conv_b, lr_w_a, lr_b_a, lr_w_x, lr_b_x, lr_lambda, lr_w_out):
    for i in range(DEPTH):
        kind = i % N_MIXERS
        j = i // N_MIXERS
        h = x + 0.5 * _swiglu(_rms(x, ffn1_norm[i]), ffn1_w_in[i], ffn1_w_out[i])
        xn = _rms(h, mix_norm[i])
        if kind == 0:
            m = _diff_attention(xn, da_w_in[j], da_q_gain[j], da_k_gain[j], da_lambda[j],
                                da_subln[j], da_w_out[j], _lambda_init(i))
        elif kind == 1:
            m = _retention(xn, rt_w_in[j], rt_subln[j], rt_w_out[j])
        elif kind == 2:
            m = _spatial_gating(xn, sg_w_in[j], sg_v_gain[j], sg_w_s[j], sg_b_s[j], sg_w_out[j])
        else:
            m = _rglru_block(xn, lr_w_in[j], lr_conv_w[j], lr_conv_b[j], lr_w_a[j], lr_b_a[j],
                             lr_w_x[j], lr_b_x[j], lr_lambda[j], lr_w_out[j])
        h = h + m.astype(h.dtype)
        x = h + 0.5 * _swiglu(_rms(h, ffn2_norm[i]), ffn2_w_in[i], ffn2_w_out[i])
    return x
```

```cpp
#include <hip/hip_runtime.h>
#include <hip/hip_cooperative_groups.h>
#include <cstdio>
#include <cstdint>
namespace cg = cooperative_groups;
namespace pg8 {
#define PG8_LAS __attribute__((address_space(3)))
typedef unsigned short bf16_t;
typedef short bf16x8 __attribute__((ext_vector_type(8)));
typedef float f32x4 __attribute__((ext_vector_type(4)));
typedef unsigned u32x4 __attribute__((ext_vector_type(4)));
constexpr int BM = 256, BK = 64, HALF = 128, HTB = HALF * BK * 2  , STAGE_BYTES = 8 * HTB, NXCD = 8, WGM = 8;

__host__ __device__ __forceinline__ int lds_byte(int r, int c) { const int st = (r >> 4) * 2 + (c >> 5), rr = r & 15, cc = c & 31, ob = rr * 64 + cc * 2; return st * 1024 + (ob ^ (((ob >> 9) & 1) << 5)); }
__host__ __device__ __forceinline__ void stage_rc(int b, int& R, int& C) { const int st = b / 1024, sb = b % 1024, swz = sb ^ (((sb >> 9) & 1) << 5); R = (st >> 1) * 16 + swz / 64; C = (st & 1) * 32 + (swz % 64) / 2; }
__host__ __device__ __forceinline__ int perm32(int rho) { const int n = rho >> 4, i = rho & 15; return 8 * (i >> 2) + 4 * n + (i & 3); }

struct Unit { int pm, pn, slot; };
struct Gemm { const bf16_t* A; const bf16_t* Bt; int M, N, K; };

struct StaticOrder {
    int nM, nN, nwg, G, c;
    __host__ __device__ void init(int M, int N, int G_, int c_) { nM = M / BM; nN = N / BM; nwg = nM * nN; G = G_; c = c_; }
    __host__ __device__ bool next(int i, Unit& u) const {
        const long L = (long)i * G + c; if (L >= nwg) return false;
        int wgid = (int)L; { const int q = nwg / NXCD, r = nwg % NXCD, xcd = wgid % NXCD, off = wgid / NXCD; wgid = (xcd < r ? xcd * (q + 1) : r * (q + 1) + (xcd - r) * q) + off; }
        const int nig = WGM * nN, gid = wgid / nig, fm = gid * WGM, gsz = (nM - fm) < WGM ? (nM - fm) : WGM;
        u.pm = fm + ((wgid % nig) % gsz); u.pn = (wgid % nig) / gsz; u.slot = i; return true;
    }
    __device__ __forceinline__ void a_ready(const Unit&) const {}
    __device__ __forceinline__ void done(const Unit&) const {}
};
__device__ __forceinline__ unsigned cvt_pk_bf16(float lo, float hi) { unsigned r; asm volatile("v_cvt_pk_bf16_f32 %0, %1, %2" : "=v"(r) : "v"(lo), "v"(hi)); return r; }
typedef float f32x2 __attribute__((ext_vector_type(2)));
__device__ __forceinline__ f32x2 gelu_pk(f32x2 v) {
    const f32x2 av = __builtin_elementwise_abs(v), d = av * 0.2316418882f + 1.0f;
    f32x2 t; t.x = __builtin_amdgcn_rcpf(d.x); t.y = __builtin_amdgcn_rcpf(d.y);
    f32x2 q = t * 0.5307027145f + (-0.7265760135f); q = q * t + 0.7107068705f; q = q * t + (-0.142248368f); q = q * t + 0.127414796f; q = q * t;
    const f32x2 s = (v * v) * (-0.72134752044f);
    f32x2 e; e.x = __builtin_amdgcn_exp2f(s.x); e.y = __builtin_amdgcn_exp2f(s.y);
    const f32x2 m = v * (q * e), r = v - m;
    f32x2 o; o.x = v.x < 0.f ? m.x : r.x; o.y = v.y < 0.f ? m.y : r.y; return o;
}
constexpr float RMS_EPS = 1e-6f;
constexpr float LOG2E = 1.4426950408889634f;
typedef unsigned u32x2 __attribute__((ext_vector_type(2)));
__device__ __forceinline__ float fast_sigmoid(float y) { return __builtin_amdgcn_rcpf(1.0f + __builtin_amdgcn_exp2f(-y * LOG2E)); }
__device__ __forceinline__ float silu_f(float x) { return x * fast_sigmoid(x); }
__device__ __forceinline__ float gelu_tanh_f(float x) { return x * fast_sigmoid(1.5957691216057308f * (x + 0.044715f * x * x * x)); }
__device__ __forceinline__ float row_sumsq16(const float* p16) { const f32x4* p = (const f32x4*)p16; const f32x4 a = p[0], b = p[1], c = p[2], d = p[3];
    return (((a[0] + a[1]) + (a[2] + a[3])) + ((b[0] + b[1]) + (b[2] + b[3]))) + (((c[0] + c[1]) + (c[2] + c[3])) + ((d[0] + d[1]) + (d[2] + d[3]))); }
constexpr int RSTD_OFF = 131072;
template <class Sched> __device__ __forceinline__ void rstd_table(PG8_LAS unsigned char* lds, const float* stat, const Sched& S, int tid) {
    if (tid < 256) {
        f32x4 v[8][4]; int nu = 0; Unit u;
#pragma unroll
        for (int i = 0; i < 8; ++i) { if (S.next(i, u)) { const f32x4* p = (const f32x4*)(stat + (size_t)(u.pm * BM + tid) * 16); v[i][0] = p[0]; v[i][1] = p[1]; v[i][2] = p[2]; v[i][3] = p[3]; nu = i + 1; }
            else { v[i][0] = v[i][1] = v[i][2] = v[i][3] = (f32x4){0.f, 0.f, 0.f, 0.f}; } }
#pragma unroll
        for (int i = 0; i < 8; ++i) if (i < nu) { const f32x4 a = v[i][0], b = v[i][1], c = v[i][2], d = v[i][3];
            const float s = (((a[0] + a[1]) + (a[2] + a[3])) + ((b[0] + b[1]) + (b[2] + b[3]))) + (((c[0] + c[1]) + (c[2] + c[3])) + ((d[0] + d[1]) + (d[2] + d[3])));
            ((PG8_LAS float*)(lds + RSTD_OFF))[i * 256 + tid] = __builtin_amdgcn_rsqf(s * (1.0f / 1024.0f) + RMS_EPS); }
        for (int i = 8; S.next(i, u); ++i) ((PG8_LAS float*)(lds + RSTD_OFF))[i * 256 + tid] = __builtin_amdgcn_rsqf(row_sumsq16(stat + (size_t)(u.pm * BM + tid) * 16) * (1.0f / 1024.0f) + RMS_EPS);
    }
    __syncthreads();
}
__device__ __forceinline__ void load_rstd(const PG8_LAS float* tab, const Unit& u, int wr, int fr, float (&rs)[2][4]) {
#pragma unroll
    for (int ai = 0; ai < 2; ++ai)
#pragma unroll
        for (int m = 0; m < 4; ++m) rs[ai][m] = tab[u.slot * 256 + ai * HALF + wr * 64 + m * 16 + fr];
}
struct EpiSwiGLU {
    static constexpr bool PERM = true, AFTER_DRAIN = false;
    bf16_t* H; const PG8_LAS float* tab;
    __device__ __forceinline__ void operator()(const f32x4 (&acc)[2][2][4][2], const Unit& u, int wr, int wc, int fr, int fq) const {
        const int row0 = u.pm * BM + wr * 64 + fr, col0 = u.pn * HALF + wc * 32 + 8 * fq;
        float rs[2][4]; load_rstd(tab, u, wr, fr, rs);
#pragma unroll
        for (int ai = 0; ai < 2; ++ai)
#pragma unroll
            for (int m = 0; m < 4; ++m) { const float r = rs[ai][m]; float h[8];
#pragma unroll
                for (int n = 0; n < 2; ++n)
#pragma unroll
                    for (int e = 0; e < 4; ++e) { const float a = acc[ai][0][m][n][e] * r, b = acc[ai][1][m][n][e] * r; h[4 * n + e] = silu_f(a) * b; }
                u32x4 w; w.x = cvt_pk_bf16(h[0], h[1]); w.y = cvt_pk_bf16(h[2], h[3]); w.z = cvt_pk_bf16(h[4], h[5]); w.w = cvt_pk_bf16(h[6], h[7]);
                *(u32x4*)(H + (size_t)(row0 + ai * HALF + m * 16) * 2816 + col0) = w; }
    }
};
struct EpiRes {
    static constexpr bool PERM = false, AFTER_DRAIN = false;
    float* out; bf16_t* xb; float* stat; float alpha; int fin;
    __device__ __forceinline__ void operator()(const f32x4 (&acc)[2][2][4][2], const Unit& u, int wr, int wc, int fr, int fq) const {
        const int row0 = u.pm * BM + wr * 64 + fr, col0 = u.pn * BM + wc * 32 + 4 * fq;
#pragma unroll
        for (int ai = 0; ai < 2; ++ai)
#pragma unroll
            for (int m = 0; m < 4; ++m) { const int row = row0 + ai * HALF + m * 16; const size_t off = (size_t)row * 1024 + col0; float ss = 0.f;
                u32x2 bs[2][2];
#pragma unroll
                for (int bj = 0; bj < 2; ++bj)
#pragma unroll
                    for (int n = 0; n < 2; ++n) bs[bj][n] = *(const u32x2*)(xb + off + bj * HALF + n * 16);
#pragma unroll
                for (int bj = 0; bj < 2; ++bj)
#pragma unroll
                    for (int n = 0; n < 2; ++n) { f32x4 o; o[0] = __uint_as_float(bs[bj][n].x << 16); o[1] = __uint_as_float(bs[bj][n].x & 0xffff0000u); o[2] = __uint_as_float(bs[bj][n].y << 16); o[3] = __uint_as_float(bs[bj][n].y & 0xffff0000u);
                        o = o + acc[ai][bj][m][n] * alpha; ss += (o[0] * o[0] + o[1] * o[1]) + (o[2] * o[2] + o[3] * o[3]);
                        if (fin) *(f32x4*)(out + off + bj * HALF + n * 16) = o;
                        else { u32x2 w; w.x = cvt_pk_bf16(o[0], o[1]); w.y = cvt_pk_bf16(o[2], o[3]); *(u32x2*)(xb + off + bj * HALF + n * 16) = w; } }
                ss += __shfl_xor(ss, 16); ss += __shfl_xor(ss, 32);
                if (fq == 0) stat[(size_t)row * 16 + u.pn * 4 + wc] = ss; }
    }
};
template <int MODE> struct EpiRoute {
    static constexpr bool PERM = true, AFTER_DRAIN = false;
    bf16_t *d0, *d1, *d2, *d3; const PG8_LAS float* tab; float* stat2; const float *g0, *g1;
    __device__ __forceinline__ void operator()(const f32x4 (&acc)[2][2][4][2], const Unit& u, int wr, int wc, int fr, int fq) const {
        const int row0 = u.pm * BM + wr * 64 + fr; const int pn = u.pn;
        float rs[2][4]; load_rstd(tab, u, wr, fr, rs);
        if (MODE == 0 && pn < 8) {
            const bool isq = pn < 4; bf16_t* dst = isq ? d0 : d1; const float* gp = isq ? g0 : g1; const float sc = isq ? 0.125f * LOG2E : 1.0f;
            f32x4 gv[2][2];
#pragma unroll
            for (int bj = 0; bj < 2; ++bj)
#pragma unroll
                for (int n = 0; n < 2; ++n) gv[bj][n] = *(const f32x4*)(gp + 32 * bj + 8 * fq + 4 * n);
            const int colb = 256 * (pn & 3) + 64 * wc + 8 * fq;
#pragma unroll
            for (int ai = 0; ai < 2; ++ai)
#pragma unroll
                for (int m = 0; m < 4; ++m) { const float r = rs[ai][m]; f32x4 v[2][2]; float ss = 0.f;
#pragma unroll
                    for (int bj = 0; bj < 2; ++bj)
#pragma unroll
                        for (int n = 0; n < 2; ++n) { v[bj][n] = acc[ai][bj][m][n] * r; ss += (v[bj][n][0] * v[bj][n][0] + v[bj][n][1] * v[bj][n][1]) + (v[bj][n][2] * v[bj][n][2] + v[bj][n][3] * v[bj][n][3]); }
                    ss += __shfl_xor(ss, 16); ss += __shfl_xor(ss, 32);
                    const float nr = __builtin_amdgcn_rsqf(ss * (1.0f / 64.0f) + RMS_EPS) * sc;
                    bf16_t* rowp = dst + (size_t)(row0 + ai * HALF + m * 16) * 1024 + colb;
#pragma unroll
                    for (int bj = 0; bj < 2; ++bj) { const f32x4 a = v[bj][0] * gv[bj][0] * nr, b = v[bj][1] * gv[bj][1] * nr;
                        u32x4 w; w.x = cvt_pk_bf16(a[0], a[1]); w.y = cvt_pk_bf16(a[2], a[3]); w.z = cvt_pk_bf16(b[0], b[1]); w.w = cvt_pk_bf16(b[2], b[3]);
                        *(u32x4*)(rowp + 32 * bj) = w; } }
            return;
        }
        bf16_t* dst; int pitch, tile; int act = 0; float sc = 1.0f; bool sq = false;
        if (MODE == 0) { dst = d2; pitch = 1024; tile = pn - 8; }
        else if (MODE == 1) { if (pn < 4) { dst = d0; pitch = 1024; tile = pn; } else if (pn < 8) { dst = d1; pitch = 1024; tile = pn - 4; sc = 0.0625f; } else if (pn < 16) { dst = d2; pitch = 2048; tile = pn - 8; } else { dst = d3; pitch = 2048; tile = pn - 16; act = 1; } }
        else if (MODE == 2) { act = 2; pitch = 3072; if (pn < 12) { dst = d0; tile = pn; } else { dst = d1; tile = pn - 12; sq = true; } }
        else { dst = d0; pitch = 3072; tile = pn; }
        const int colb = 256 * tile + 32 * wc + 8 * fq;
#pragma unroll
        for (int ai = 0; ai < 2; ++ai)
#pragma unroll
            for (int m = 0; m < 4; ++m) { const int row = row0 + ai * HALF + m * 16; const float r = rs[ai][m] * sc; float ss = 0.f;
                bf16_t* rowp = dst + (size_t)row * pitch + colb;
#pragma unroll
                for (int bj = 0; bj < 2; ++bj) { float h[8];
#pragma unroll
                    for (int n = 0; n < 2; ++n)
#pragma unroll
                        for (int e = 0; e < 4; ++e) { float x = acc[ai][bj][m][n][e] * r; if (MODE == 1) { if (act == 1) x = silu_f(x); } if (MODE == 2) { x = gelu_tanh_f(x); ss += x * x; } h[4 * n + e] = x; }
                    u32x4 w; w.x = cvt_pk_bf16(h[0], h[1]); w.y = cvt_pk_bf16(h[2], h[3]); w.z = cvt_pk_bf16(h[4], h[5]); w.w = cvt_pk_bf16(h[6], h[7]);
                    *(u32x4*)(rowp + bj * HALF) = w; }
                if (MODE == 2) { ss += __shfl_xor(ss, 16); ss += __shfl_xor(ss, 32); if (sq && fq == 0) stat2[(size_t)row * 48 + tile * 4 + wc] = ss; } }
    }
};
template <class Epi, class Sched, bool ALIGN_EPI = false, bool SP2 = false>
__device__ __forceinline__ void gemm_phase(PG8_LAS unsigned char* lds, const Gemm g, const Sched& S, const Epi& E) {
    int tid_o = threadIdx.x; asm volatile("" : "+v"(tid_o)); const int tid = tid_o, wid = __builtin_amdgcn_readfirstlane(tid >> 6), lane = tid & 63, wr = wid >> 2, wc = wid & 3, fr = lane & 15, fq = lane >> 4;
    const int K = g.K, nt = K / BK;
    unsigned voffA[2], voffB[2];
#pragma unroll
    for (int i = 0; i < 2; ++i) { int R, C; stage_rc(tid * 16 + i * 8192, R, C); const int Rb = Epi::PERM ? ((R & ~31) + perm32(R & 31)) : R;
        voffA[i] = (unsigned)(R * K + C) * 2u; voffB[i] = (unsigned)(Rb * K + C) * 2u; }
    const size_t kstep = (size_t)(BK * 2);
    const size_t hstep = (size_t)HALF * K * 2;
    const size_t tstep = 2 * hstep;
    const unsigned ldsw = (unsigned)wid * 1024u;
    const int aoff = lds_byte(wr * 64 + fr, fq * 8), boff = lds_byte(wc * 32 + fr, fq * 8);
#define PG8_SA(b, h) (((b) * 2 + (h)) * HTB)
#define PG8_SB(b, h) ((4 + (b) * 2 + (h)) * HTB)
#define PG8_STAGE(bufoff, gbase, voff) do { _Pragma("unroll") for (int _i = 0; _i < 2; ++_i) \
        __builtin_amdgcn_global_load_lds((const unsigned*)((const char*)(gbase) + (voff)[_i]), (PG8_LAS unsigned*)(lds + (bufoff) + ldsw + _i * 8192), 16, 0, 0); } while (0)
#define PG8_LDA(dst, b, h) do { _Pragma("unroll") for (int m = 0; m < 4; ++m) _Pragma("unroll") for (int k = 0; k < 2; ++k) dst[m][k] = *(const PG8_LAS bf16x8*)(lds + PG8_SA(b, h) + aoff + m * 2048 + k * 1024); } while (0)
#define PG8_LDB(dst, b, h) do { _Pragma("unroll") for (int n = 0; n < 2; ++n) _Pragma("unroll") for (int k = 0; k < 2; ++k) dst[n][k] = *(const PG8_LAS bf16x8*)(lds + PG8_SB(b, h) + boff + n * 2048 + k * 1024); } while (0)
#define PG8_MMA(ai, bj, At, Bt) do { __builtin_amdgcn_s_setprio(1); _Pragma("unroll") for (int m = 0; m < 4; ++m) _Pragma("unroll") for (int n = 0; n < 2; ++n) _Pragma("unroll") for (int k = 0; k < 2; ++k) \
        acc[ai][bj][m][n] = __builtin_amdgcn_mfma_f32_16x16x32_bf16(Bt[n][k], At[m][k], acc[ai][bj][m][n], 0, 0, 0); __builtin_amdgcn_s_setprio(0); } while (0)
#define PG8_WAIT_V(n) asm volatile("s_waitcnt vmcnt(" #n ")" ::: "memory")
#define PG8_WAIT_L(n) asm volatile("s_waitcnt lgkmcnt(" #n ")" ::: "memory")
#define PG8_BAR __builtin_amdgcn_s_barrier()
#define PG8_SCHED __builtin_amdgcn_sched_barrier(0)
    Unit cur, nxt; int ui = 0;
    if (!S.next(0, cur)) return;
    f32x4 acc[2][2][4][2];
#pragma unroll
    for (int a = 0; a < 2; ++a)
#pragma unroll
        for (int b = 0; b < 2; ++b)
#pragma unroll
            for (int m = 0; m < 4; ++m)
#pragma unroll
                for (int n = 0; n < 2; ++n) acc[a][b][m][n] = (f32x4){0.f, 0.f, 0.f, 0.f};
    bf16x8 At[4][2], B0[2][2], B1[2][2];
    const char* cA = (const char*)g.A + (size_t)cur.pm * tstep; const char* cB = (const char*)g.Bt + (size_t)cur.pn * tstep;
    S.a_ready(cur);
    if constexpr (SP2) {
        PG8_STAGE(PG8_SB(0, 0), cB, voffB); PG8_STAGE(PG8_SB(0, 1), cB + hstep, voffB); PG8_STAGE(PG8_SA(0, 0), cA, voffA); PG8_STAGE(PG8_SA(0, 1), cA + hstep, voffA);
        if (wr == 1) PG8_BAR;
        PG8_WAIT_V(2); PG8_BAR;
        PG8_STAGE(PG8_SB(1, 0), cB + kstep, voffB); PG8_STAGE(PG8_SA(1, 0), cA + kstep, voffA); PG8_STAGE(PG8_SB(1, 1), cB + hstep + kstep, voffB);
        PG8_WAIT_V(6); PG8_BAR;
    } else {
        PG8_STAGE(PG8_SB(0, 0), cB, voffB); PG8_STAGE(PG8_SA(0, 0), cA, voffA); PG8_STAGE(PG8_SB(0, 1), cB + hstep, voffB); PG8_STAGE(PG8_SA(0, 1), cA + hstep, voffA);
        if (wr == 1) PG8_BAR;
        PG8_WAIT_V(4); PG8_BAR;
        PG8_STAGE(PG8_SB(1, 0), cB + kstep, voffB); PG8_STAGE(PG8_SA(1, 0), cA + kstep, voffA); PG8_STAGE(PG8_SB(1, 1), cB + hstep + kstep, voffB);
        PG8_WAIT_V(6); PG8_BAR;
    }
    for (;;) {
        const bool has_next = S.next(ui + 1, nxt);
        const char* nA = has_next ? (const char*)g.A + (size_t)nxt.pm * tstep : cA; const char* nB = has_next ? (const char*)g.Bt + (size_t)nxt.pn * tstep : cB;
        for (int t = 0; t < nt; t += 2) {
            const bool last = (t == nt - 2);
            const char* a1 = cA + (size_t)(t + 1) * kstep;
            const char* a2 = last ? nA : cA + (size_t)(t + 2) * kstep; const char* b2 = last ? nB : cB + (size_t)(t + 2) * kstep;
            const char* a3 = a2 + kstep; const char* b3 = b2 + kstep;
            if (last && has_next) S.a_ready(nxt);
            if constexpr (SP2) {
            PG8_LDB(B0, 0, 0); PG8_LDB(B1, 0, 1); PG8_SCHED; PG8_LDA(At, 0, 0); PG8_STAGE(PG8_SA(1, 1), a1 + hstep, voffA);
            PG8_WAIT_V(8); PG8_WAIT_L(0); PG8_BAR; PG8_MMA(0, 0, At, B0); PG8_MMA(0, 1, At, B1); PG8_BAR; PG8_SCHED;
            PG8_LDA(At, 0, 1); PG8_STAGE(PG8_SB(0, 0), b2, voffB); PG8_STAGE(PG8_SB(0, 1), b2 + hstep, voffB); PG8_STAGE(PG8_SA(0, 0), a2, voffA);
            PG8_WAIT_V(8); PG8_WAIT_L(0); PG8_BAR; PG8_MMA(1, 0, At, B0); PG8_MMA(1, 1, At, B1); PG8_BAR; PG8_SCHED;
            PG8_LDB(B0, 1, 0); PG8_LDB(B1, 1, 1); PG8_SCHED; PG8_LDA(At, 1, 0); PG8_STAGE(PG8_SA(0, 1), a2 + hstep, voffA);
            PG8_WAIT_V(8); PG8_WAIT_L(0); PG8_BAR; PG8_MMA(0, 0, At, B0); PG8_MMA(0, 1, At, B1); PG8_BAR; PG8_SCHED;
            PG8_LDA(At, 1, 1); PG8_STAGE(PG8_SB(1, 0), b3, voffB); PG8_STAGE(PG8_SB(1, 1), b3 + hstep, voffB); PG8_STAGE(PG8_SA(1, 0), a3, voffA);
            PG8_WAIT_V(8); PG8_WAIT_L(0); PG8_BAR; PG8_MMA(1, 0, At, B0); PG8_MMA(1, 1, At, B1); PG8_BAR; PG8_SCHED;
            } else {
            PG8_LDB(B0, 0, 0); PG8_SCHED; PG8_LDA(At, 0, 0); PG8_STAGE(PG8_SA(1, 1), a1 + hstep, voffA);
            PG8_WAIT_L(8); PG8_BAR; PG8_WAIT_L(0); PG8_MMA(0, 0, At, B0); PG8_BAR; PG8_SCHED;
            PG8_LDB(B1, 0, 1); PG8_STAGE(PG8_SB(0, 0), b2, voffB);
            PG8_BAR; PG8_WAIT_L(0); PG8_MMA(0, 1, At, B1); PG8_BAR;
            PG8_LDA(At, 0, 1); PG8_STAGE(PG8_SA(0, 0), a2, voffA);
            PG8_BAR; PG8_WAIT_L(0); PG8_MMA(1, 0, At, B0); PG8_BAR; PG8_SCHED;
            PG8_STAGE(PG8_SB(0, 1), b2 + hstep, voffB);
            PG8_WAIT_V(6); PG8_BAR; PG8_MMA(1, 1, At, B1); PG8_BAR;
            PG8_LDB(B0, 1, 0); PG8_SCHED; PG8_LDA(At, 1, 0); PG8_STAGE(PG8_SA(0, 1), a2 + hstep, voffA);
            PG8_WAIT_L(8); PG8_BAR; PG8_WAIT_L(0); PG8_MMA(0, 0, At, B0); PG8_BAR; PG8_SCHED;
            PG8_LDB(B1, 1, 1); PG8_STAGE(PG8_SB(1, 0), b3, voffB);
            PG8_BAR; PG8_WAIT_L(0); PG8_MMA(0, 1, At, B1); PG8_BAR;
            PG8_LDA(At, 1, 1); PG8_STAGE(PG8_SA(1, 0), a3, voffA);
            PG8_BAR; PG8_WAIT_L(0); PG8_MMA(1, 0, At, B0); PG8_BAR; PG8_SCHED;
            PG8_STAGE(PG8_SB(1, 1), b3 + hstep, voffB);
            PG8_WAIT_V(6); PG8_BAR; PG8_MMA(1, 1, At, B1); PG8_BAR;
            }
        }
        if constexpr (ALIGN_EPI) { if (wr == 0) PG8_BAR; }
        if constexpr (!Epi::AFTER_DRAIN) { E(acc, cur, wr, wc, fr, fq); S.done(cur); }
        if (!has_next) break;
#pragma unroll
        for (int a = 0; a < 2; ++a)
#pragma unroll
            for (int b = 0; b < 2; ++b)
#pragma unroll
                for (int m = 0; m < 4; ++m)
#pragma unroll
                    for (int n = 0; n < 2; ++n) acc[a][b][m][n] = (f32x4){0.f, 0.f, 0.f, 0.f};
        cur = nxt; cA = nA; cB = nB; ++ui;
        if constexpr (ALIGN_EPI) { if (wr == 1) PG8_BAR; }
    }
    PG8_WAIT_V(0);
    if constexpr (!ALIGN_EPI) { if (wr == 0) PG8_BAR; }
    PG8_BAR;
    if constexpr (Epi::AFTER_DRAIN) { E.fused(acc, cur, wr, wc, fr, fq, lds, wid, lane); S.done(cur); }
#undef PG8_SA
#undef PG8_SB
#undef PG8_STAGE
#undef PG8_LDA
#undef PG8_LDB
#undef PG8_MMA
#undef PG8_WAIT_V
#undef PG8_WAIT_L
#undef PG8_BAR
#undef PG8_SCHED
}
}
#include <hip/hip_bf16.h>
#include <cmath>
namespace attn_body {
using bf16=__hip_bfloat16;
using bf16x8=__attribute__((ext_vector_type(8)))short;
using s16x4=__attribute__((ext_vector_type(4)))short;
using f32x16=__attribute__((ext_vector_type(16)))float;
using u32x4=__attribute__((ext_vector_type(4)))unsigned;
constexpr int SEQ=16384,D=64,DM=1024;
constexpr int NW=8,QBLK=32,QB=QBLK*NW,KVBLK=64,NQB=SEQ/QB;
constexpr int ATTN_PITCH=DM, ATTN_UNIT_ROWS=QB;
__device__ __forceinline__ int crow(int r,int hi){return (r&3)+8*(r>>2)+4*hi;}
#define SBAR() __builtin_amdgcn_sched_barrier(0)
__device__ __forceinline__ void cmask(f32x16&p0,f32x16&p1,int jb,int qrel,int hi){
  const float NEG=-INFINITY; int kb=64*jb+4*hi;
  #pragma unroll
  for(int r=0;r<16;++r){int kv=kb+(r&3)+8*(r>>2); if(kv>qrel)p0[r]=NEG; if(kv+32>qrel)p1[r]=NEG;}
}

constexpr int NSLOT=3, SLOTB=8192;
constexpr int LDS_K=0, LDS_V=NSLOT*SLOTB, LDS_WS=2*NSLOT*SLOTB, LDS_OST=LDS_WS+NW*64*4, LDS_BYTES=LDS_OST+NW*4096;
constexpr float C2=0.125f*1.4426950408889634f;
__device__ __forceinline__ void glds16(const void*gsrc,unsigned lds_dst){unsigned keep;
  asm volatile("s_mov_b32 %0, m0\n\ts_mov_b32 m0, %2\n\ts_nop 0\n\tglobal_load_lds_dwordx4 %1, off\n\ts_mov_b32 m0, %0":"=&s"(keep):"v"(gsrc),"s"(lds_dst):"memory");}
__device__ __forceinline__ float max3f(float a,float b,float c){float r;asm("v_max3_f32 %0, %1, %2, %3":"=v"(r):"v"(a),"v"(b),"v"(c));return r;}
__device__ __forceinline__ float max2f(float a,float b){float r;asm("v_max_f32_e32 %0, %1, %2":"=v"(r):"v"(a),"v"(b));return r;}
__device__ __forceinline__ float fadd_s(float a,float b){float r;asm("v_add_f32_e32 %0, %1, %2":"=v"(r):"v"(a),"v"(b));return r;}
__device__ __forceinline__ float fsub_s(float a,float b){float r;asm("v_sub_f32_e32 %0, %1, %2":"=v"(r):"v"(a),"v"(b));return r;}
typedef float f32x2_t __attribute__((ext_vector_type(2))); typedef __bf16 bf16x2_t __attribute__((ext_vector_type(2)));
__device__ __forceinline__ unsigned cvtpk_s(float lo,float hi){f32x2_t v={lo,hi};bf16x2_t b=__builtin_convertvector(v,bf16x2_t);return __builtin_bit_cast(unsigned,b);}
#define WAIT_BAR(N) asm volatile("s_waitcnt vmcnt(" #N ") lgkmcnt(0)\n\ts_barrier":::"memory")

__device__ __forceinline__ void qkt(f32x16&p0,f32x16&p1,const char*Kslot,const bf16x8*qr,const f32x16&negm,int r32,int hi){
  const char*kb=Kslot+hi*1024+r32*16;
  #pragma unroll
  for(int d0=0;d0<4;++d0){
    const bf16x8 b0=*reinterpret_cast<const bf16x8*>(kb+d0*2048);
    const bf16x8 b1=*reinterpret_cast<const bf16x8*>(kb+d0*2048+512);
    if(d0==0){p0=__builtin_amdgcn_mfma_f32_32x32x16_bf16(b0,qr[0],negm,0,0,0);p1=__builtin_amdgcn_mfma_f32_32x32x16_bf16(b1,qr[0],negm,0,0,0);}
    else{p0=__builtin_amdgcn_mfma_f32_32x32x16_bf16(b0,qr[d0],p0,0,0,0);p1=__builtin_amdgcn_mfma_f32_32x32x16_bf16(b1,qr[d0],p1,0,0,0);}}
}
typedef __attribute__((address_space(3))) const char* lds_cptr;
typedef short v4i16_t __attribute__((ext_vector_type(4)));
__device__ __forceinline__ void kload8(bf16x8*kf,lds_cptr kp){
  kf[0]=*(const __attribute__((address_space(3))) bf16x8*)(kp);      kf[1]=*(const __attribute__((address_space(3))) bf16x8*)(kp+512);
  kf[2]=*(const __attribute__((address_space(3))) bf16x8*)(kp+2048); kf[3]=*(const __attribute__((address_space(3))) bf16x8*)(kp+2560);
  kf[4]=*(const __attribute__((address_space(3))) bf16x8*)(kp+4096); kf[5]=*(const __attribute__((address_space(3))) bf16x8*)(kp+4608);
  kf[6]=*(const __attribute__((address_space(3))) bf16x8*)(kp+6144); kf[7]=*(const __attribute__((address_space(3))) bf16x8*)(kp+6656);
}
__device__ __forceinline__ void kload2(bf16x8*kf,lds_cptr kp,int j){ kf[2*j]=*(const __attribute__((address_space(3))) bf16x8*)(kp+j*2048); kf[2*j+1]=*(const __attribute__((address_space(3))) bf16x8*)(kp+j*2048+512); }
__device__ __forceinline__ s16x4 vtr(lds_cptr p){ return __builtin_bit_cast(s16x4,__builtin_amdgcn_ds_read_tr16_b64_v4i16((__attribute__((address_space(3))) v4i16_t*)p)); }
__device__ __forceinline__ float rowmax(const f32x16&p0,const f32x16&p1){
  float a=max3f(p0[0],p0[1],p1[0]),b=max3f(p0[2],p0[3],p1[1]);a=max3f(a,p1[2],p1[3]);
  #pragma unroll
  for(int r=4;r<16;r+=4){a=max3f(a,p0[r],p0[r+1]);b=max3f(b,p0[r+2],p0[r+3]);a=max3f(a,p1[r],p1[r+1]);b=max3f(b,p1[r+2],p1[r+3]);}
  const float m=max2f(a,b);
  auto rr=__builtin_amdgcn_permlane32_swap(__float_as_uint(m),__float_as_uint(m),false,false);
  return max2f(__uint_as_float(rr[0]),__uint_as_float(rr[1]));
}
__device__ __forceinline__ void pv(f32x16*o,int vb,bf16x8 pa0,bf16x8 pa1,bf16x8 pa2,bf16x8 pa3){
  #pragma unroll
  for(int d0=0;d0<2;++d0){s16x4 lo[4],hi[4];
    #pragma unroll
    for(int ks=0;ks<4;++ks){
      asm volatile("ds_read_b64_tr_b16 %0,%1 offset:%c2":"=&v"(lo[ks]):"v"(vb),"i"(d0*4096+ks*1024):"memory");
      asm volatile("ds_read_b64_tr_b16 %0,%1 offset:%c2":"=&v"(hi[ks]):"v"(vb),"i"(d0*4096+ks*1024+512):"memory");}
    asm volatile("s_waitcnt lgkmcnt(0)":::"memory");SBAR();
    #define PK(k) (bf16x8){lo[k][0],lo[k][1],lo[k][2],lo[k][3],hi[k][0],hi[k][1],hi[k][2],hi[k][3]}
    o[d0]=__builtin_amdgcn_mfma_f32_32x32x16_bf16(pa0,PK(0),o[d0],0,0,0);
    o[d0]=__builtin_amdgcn_mfma_f32_32x32x16_bf16(pa1,PK(1),o[d0],0,0,0);
    o[d0]=__builtin_amdgcn_mfma_f32_32x32x16_bf16(pa2,PK(2),o[d0],0,0,0);
    o[d0]=__builtin_amdgcn_mfma_f32_32x32x16_bf16(pa3,PK(3),o[d0],0,0,0);
    #undef PK
  }
}

#ifndef ATTN_STORE16
#define ATTN_STORE16(p,v) (*(u32x4*)(p)=(v))
#endif
template<int THRL> __device__ __forceinline__ void attn_unit(int qb,int t0,float sl2,const bf16*Qh,const bf16*__restrict__ Kh0,const bf16*__restrict__ Vh0,bf16*Oh,char*shm){
  int tid_o=threadIdx.x; asm volatile("":"+v"(tid_o)); const int tid=tid_o,lane=tid&63,r32=lane&31,hi=lane>>5; const int wid=__builtin_amdgcn_readfirstlane(tid>>6);
  const int q0=qb*QB;
  const bf16*Qw=Qh+(long)(q0+wid*QBLK)*DM;
  const bf16*Kh=Kh0+(long)t0*KVBLK*DM,*Vh=Vh0+(long)t0*KVBLK*DM;
  const unsigned lds0=(unsigned)(uintptr_t)shm;
  float*wsf=(float*)(shm+LDS_WS)+wid*64;
  const bf16*ksrc=Kh+(long)lane*DM+wid*8;
  const bf16*vsrc=Vh+(long)(16*(wid&3)+(lane>>2))*DM+(wid>>2)*32+(lane&3)*8;
  const unsigned kdst=lds0+LDS_K+wid*1024, vdst=lds0+LDS_V+wid*1024;
  #define DMA_K(t,slot) glds16(ksrc+(long)(t)*KVBLK*DM,(unsigned)__builtin_amdgcn_readfirstlane(kdst+(slot)))
  #define DMA_V(t,slot) glds16(vsrc+(long)(t)*KVBLK*DM,(unsigned)__builtin_amdgcn_readfirstlane(vdst+(slot)))
  const int vb0=(int)(lds0+LDS_V)+((lane>>4)&1)*32+(lane&3)*8+(4*hi+((lane&15)>>2))*64;
  const char*Kbase=shm+LDS_K; bf16x8 kf[8];
  const lds_cptr shm3=(lds_cptr)shm; const lds_cptr kp0=shm3+LDS_K+hi*1024+r32*16; const lds_cptr vp0=shm3+LDS_V+((lane>>4)&1)*32+(lane&3)*8+(4*hi+((lane&15)>>2))*64;
  const int NT=(q0+QB)/KVBLK-t0;
  DMA_K(0,0);DMA_V(0,0);DMA_K(1,SLOTB);
  bf16x8 qr[4];
  #pragma unroll
  for(int d0=0;d0<4;++d0)qr[d0]=*reinterpret_cast<const bf16x8*>(&Qw[(long)r32*DM+d0*16+hi*8]);
  float mhat=0.f,l_reg=0.f;f32x16 o[2];o[0]=f32x16{};o[1]=f32x16{};f32x16 negm=f32x16{};asm volatile("":"+v"(negm));
  const int qrel=wid*QBLK+r32;
  const float sl32=32.f*sl2, sl64=64.f*sl2; const float bt0=sl2*(float)(64*t0+4*hi-(q0+qrel));
  #define CMASK(P0,P1,t) do{int jb_=(t)-(NT-4); if(jb_>=0)cmask(P0,P1,jb_,qrel,hi);}while(0)
  bool resc=false;
  #define START(P0,P1) do{ const float rm=rowmax(P0,P1); resc=false; \
    { const float dl=rm; mhat=fadd_s(mhat,dl); \
      _Pragma("unroll") for(int r=0;r<16;++r){P0[r]=fsub_s(P0[r],dl);P1[r]=fsub_s(P1[r],dl);} \
      _Pragma("unroll") for(int r=0;r<16;++r)negm[r]=(bt0+sl64-mhat)+sl2*(float)((r&3)+8*(r>>2)); asm volatile("":"+v"(negm)); } \
    _Pragma("unroll") for(int r=0;r<16;++r)P0[r]=__builtin_amdgcn_exp2f(P0[r]); }while(0)
  #define RESC() do{ if(resc){ asm volatile("s_waitcnt lgkmcnt(0)":::"memory"); \
      _Pragma("unroll") for(int d_=0;d_<2;++d_) _Pragma("unroll") for(int r=0;r<16;++r)o[d_][r]*=wsf[crow(r,hi)]; } }while(0)
  f32x16 pA0,pA1,pB0,pB1;
  int sl_prev=0,sl_cur=0,sl_next=SLOTB;
  #define ROT() do{sl_prev=sl_cur;sl_cur=sl_next;sl_next=(sl_next==(NSLOT-1)*SLOTB)?0:sl_next+SLOTB;}while(0)
  DMA_K(2,2*SLOTB);
  WAIT_BAR(3);
  qkt(pA0,pA1,Kbase,qr,negm,r32,hi);asm volatile("s_nop 15\n\ts_nop 7":"+v"(pA0),"+v"(pA1));
  _Pragma("unroll") for(int r=0;r<16;++r){const float bb=bt0+sl2*(float)((r&3)+8*(r>>2)); pA0[r]+=bb; pA1[r]+=bb+sl32;}
  CMASK(pA0,pA1,0);
  START(pA0,pA1);
  _Pragma("unroll") for(int r=0;r<16;++r)pA1[r]=__builtin_amdgcn_exp2f(pA1[r]);
  WAIT_BAR(0);
  DMA_K(3,0);DMA_V(1,SLOTB);
  ROT();
  kload8(kf,kp0+sl_cur);
  WAIT_BAR(2);
  s16x4 vlo[8],vhi[8]; u32x4 pw0,pw1,pw2,pw3;
  #define PKW(P,B) cvtpk_s(P[B],P[B+1])
  #define PAF(k) __builtin_bit_cast(bf16x8,pw##k)
  #define VFR(i) (bf16x8){vlo[i][0],vlo[i][1],vlo[i][2],vlo[i][3],vhi[i][0],vhi[i][1],vhi[i][2],vhi[i][3]}
  #define PIN(x) asm volatile("":"+v"(x))
  #define MX3(a,b,c) __builtin_fmaxf(__builtin_fmaxf((a),(b)),(c))
  #define GAPA(MF,A0,A1,A2,A3,W0,W1,PW) do{ MF; sacc+=A0; sacc+=A1; sacc+=A2; sacc+=A3; PIN(sacc); W0; W1; PIN(PW); SBAR(); }while(0)
  #define EX(v) __builtin_amdgcn_exp2f(v)
  #define GAPB(MF,X,B) do{ MF; X[B]=EX(X[B]); X[B+1]=EX(X[B+1]); X[B+2]=EX(X[B+2]); X[B+3]=EX(X[B+3]); PIN(X); SBAR(); }while(0)
  #define VRD(i) do{ vlo[i]=vtr(vp_+(((i)>>2)*4096+((i)&3)*1024)); vhi[i]=vtr(vp_+(((i)>>2)*4096+((i)&3)*1024+512)); }while(0)
  #define KRD(G,j) do{ if(G){ kload2(kf,kp0+sl_next,j); SBAR(); } }while(0)
  #define STEP(C0,C1,P0,P1,t,GK,GV,GL) do{ SBAR(); \
    const lds_cptr vp_=vp0+sl_prev; \
    VRD(0); SBAR(); float sacc=(P0[0]+P0[1]); \
    GAPA(C0=__builtin_amdgcn_mfma_f32_32x32x16_bf16(kf[0],qr[0],negm,0,0,0), P0[2],P0[3],P0[4],P0[5],     pw0[0]=PKW(P0,0), pw0[1]=PKW(P0,2), pw0); \
    VRD(4); SBAR(); GAPA(C1=__builtin_amdgcn_mfma_f32_32x32x16_bf16(kf[1],qr[0],negm,0,0,0), P0[6],P0[7],P0[8],P0[9],     pw0[2]=PKW(P0,4), pw0[3]=PKW(P0,6), pw0); \
    VRD(1); SBAR(); GAPA(C0=__builtin_amdgcn_mfma_f32_32x32x16_bf16(kf[2],qr[1],C0,0,0,0),   P0[10],P0[11],P0[12],P0[13], pw1[0]=PKW(P0,8), pw1[1]=PKW(P0,10), pw1); \
    VRD(5); SBAR(); GAPA(C1=__builtin_amdgcn_mfma_f32_32x32x16_bf16(kf[3],qr[1],C1,0,0,0),   P0[14],P0[15],P1[0],P1[1],   pw1[2]=PKW(P0,12),pw1[3]=PKW(P0,14), pw1); \
    VRD(2); SBAR(); GAPA(C0=__builtin_amdgcn_mfma_f32_32x32x16_bf16(kf[4],qr[2],C0,0,0,0),   P1[2],P1[3],P1[4],P1[5],     pw2[0]=PKW(P1,0), pw2[1]=PKW(P1,2), pw2); \
    VRD(6); SBAR(); GAPA(C1=__builtin_amdgcn_mfma_f32_32x32x16_bf16(kf[5],qr[2],C1,0,0,0),   P1[6],P1[7],P1[8],P1[9],     pw2[2]=PKW(P1,4), pw2[3]=PKW(P1,6), pw2); \
    VRD(3); SBAR(); GAPA(C0=__builtin_amdgcn_mfma_f32_32x32x16_bf16(kf[6],qr[3],C0,0,0,0),   P1[10],P1[11],P1[12],P1[13], pw3[0]=PKW(P1,8), pw3[1]=PKW(P1,10), pw3); \
    VRD(7); SBAR(); GAPA(C1=__builtin_amdgcn_mfma_f32_32x32x16_bf16(kf[7],qr[3],C1,0,0,0),   P1[14],P1[15],0.f,0.f,       pw3[2]=PKW(P1,12),pw3[3]=PKW(P1,14), pw3); \
    l_reg+=sacc; \
    if(GK){DMA_K((t)+3,sl_cur);} if(GV){DMA_V((t)+1,sl_next);} \
    _Pragma("unroll") for(int r=0;r<16;++r){C1[r]+=sl32; negm[r]+=sl64;} \
    CMASK(C0,C1,t); \
    { float a=MX3(C0[0],C0[1],C1[0]),b=MX3(C0[2],C0[3],C1[1]); a=MX3(a,C1[2],C1[3]); \
      _Pragma("unroll") for(int r=4;r<16;r+=4){a=MX3(a,C0[r],C0[r+1]);b=MX3(b,C0[r+2],C0[r+3]);a=MX3(a,C1[r],C1[r+1]);b=MX3(b,C1[r+2],C1[r+3]);} \
      float rm=__builtin_fmaxf(a,b); { auto rr=__builtin_amdgcn_permlane32_swap(__float_as_uint(rm),__float_as_uint(rm),false,false); rm=__builtin_fmaxf(__uint_as_float(rr[0]),__uint_as_float(rr[1])); } \
      resc=false; \
      if(__builtin_expect(__any(rm>(float)THRL),0)){ const float dl=__builtin_fmaxf(rm,0.f); mhat+=dl; \
        _Pragma("unroll") for(int r=0;r<16;++r){C0[r]-=dl;C1[r]-=dl;} \
        _Pragma("unroll") for(int r=0;r<16;++r)negm[r]-=dl; asm volatile("":"+v"(negm)); \
        const float f=__builtin_amdgcn_exp2f(-dl); l_reg*=f; if(hi==0)wsf[r32]=f; resc=true; } } \
    SBAR(); \
    GAPB(o[0]=__builtin_amdgcn_mfma_f32_32x32x16_bf16(PAF(0),VFR(0),o[0],0,0,0), C0,0); \
    GAPB(o[1]=__builtin_amdgcn_mfma_f32_32x32x16_bf16(PAF(0),VFR(4),o[1],0,0,0), C0,4); \
    KRD(GL,0); GAPB(o[0]=__builtin_amdgcn_mfma_f32_32x32x16_bf16(PAF(1),VFR(1),o[0],0,0,0), C0,8); \
    KRD(GL,1); GAPB(o[1]=__builtin_amdgcn_mfma_f32_32x32x16_bf16(PAF(1),VFR(5),o[1],0,0,0), C0,12); \
    KRD(GL,2); GAPB(o[0]=__builtin_amdgcn_mfma_f32_32x32x16_bf16(PAF(2),VFR(2),o[0],0,0,0), C1,0); \
    KRD(GL,3); GAPB(o[1]=__builtin_amdgcn_mfma_f32_32x32x16_bf16(PAF(2),VFR(6),o[1],0,0,0), C1,4); \
    GAPB(o[0]=__builtin_amdgcn_mfma_f32_32x32x16_bf16(PAF(3),VFR(3),o[0],0,0,0), C1,8); \
    GAPB(o[1]=__builtin_amdgcn_mfma_f32_32x32x16_bf16(PAF(3),VFR(7),o[1],0,0,0), C1,12); \
    }while(0)
  int t=1;
  #undef CMASK
  #define CMASK(P0,P1,t) do{}while(0)
  for(;t+5<NT;t+=2){
    STEP(pB0,pB1,pA0,pA1,t,true,true,true);     WAIT_BAR(2); RESC(); ROT();
    STEP(pA0,pA1,pB0,pB1,t+1,true,true,true);   WAIT_BAR(2); RESC(); ROT();
  }
  #undef CMASK
  #define CMASK(P0,P1,t) do{int jb_=(t)-(NT-4); if(jb_>=0)cmask(P0,P1,jb_,qrel,hi);}while(0)
  #define ENDW(tt) do{ if((tt)+3<NT){WAIT_BAR(2);} else if((tt)+2<NT){WAIT_BAR(1);} else {WAIT_BAR(0);} }while(0)
  for(;t+1<NT;t+=2){
    STEP(pB0,pB1,pA0,pA1,t,(t+3<NT),(t+1<NT),(t+1<NT));       ENDW(t);   RESC(); ROT();
    STEP(pA0,pA1,pB0,pB1,t+1,(t+4<NT),(t+2<NT),(t+2<NT));     ENDW(t+1); RESC(); ROT();
  }
  STEP(pB0,pB1,pA0,pA1,NT-1,false,false,false); RESC();
  { float sacc=pB0[0]+pB0[1]; _Pragma("unroll") for(int r=2;r<16;++r)sacc+=pB0[r]; _Pragma("unroll") for(int r=0;r<16;++r)sacc+=pB1[r]; l_reg+=sacc;
    pw0=(u32x4){PKW(pB0,0),PKW(pB0,2),PKW(pB0,4),PKW(pB0,6)};pw1=(u32x4){PKW(pB0,8),PKW(pB0,10),PKW(pB0,12),PKW(pB0,14)};pw2=(u32x4){PKW(pB1,0),PKW(pB1,2),PKW(pB1,4),PKW(pB1,6)};pw3=(u32x4){PKW(pB1,8),PKW(pB1,10),PKW(pB1,12),PKW(pB1,14)};
    SBAR(); pv(o,vb0+sl_cur,PAF(0),PAF(1),PAF(2),PAF(3)); }
  #undef PKW
  #undef PAF
  #undef VFR
  #undef PIN
  #undef MX3
  #undef GAPA
  #undef GAPB
  #undef EX
  #undef VRD
  #undef KRD
  #undef STEP
  #undef ENDW
  {auto rr=__builtin_amdgcn_permlane32_swap(__float_as_uint(l_reg),__float_as_uint(l_reg),false,false);l_reg=__uint_as_float(rr[0])+__uint_as_float(rr[1]);}
  if(hi==0)wsf[32+r32]=l_reg;asm volatile("s_waitcnt lgkmcnt(0)":::"memory");
  float rli[16];
  #pragma unroll
  for(int r=0;r<16;++r)rli[r]=__builtin_amdgcn_rcpf(wsf[32+crow(r,hi)]);
  bf16*Ow=Oh+(long)(q0+wid*QBLK)*DM;
  { bf16*stg=(bf16*)(shm+LDS_OST)+wid*2048;
    #pragma unroll
    for(int r=0;r<16;++r){const int orow=crow(r,hi);
      #pragma unroll
      for(int d0=0;d0<2;++d0)stg[orow*64+d0*32+r32]=__float2bfloat16(o[d0][r]*rli[r]);}
    asm volatile("s_waitcnt lgkmcnt(0)":::"memory");
    #pragma unroll
    for(int i=0;i<4;++i){const int row=i*8+(lane>>3),ch=lane&7; const u32x4 v=*(const u32x4*)(stg+row*64+ch*8); ATTN_STORE16(Ow+(long)row*DM+ch*8,v);} }
  asm volatile("s_waitcnt lgkmcnt(0)\n\ts_barrier":::"memory");
  #undef DMA_K
  #undef DMA_V
  #undef CMASK
  #undef START
  #undef RESC
  #undef ROT
}
constexpr int ATTN_LDS_BYTES=LDS_BYTES;
#undef SBAR
#undef WAIT_BAR
}
#define LAS __attribute__((address_space(3)))
#define DI __device__ __forceinline__
typedef unsigned short bfu;
typedef short bf16x8 __attribute__((ext_vector_type(8)));
typedef float f32x4 __attribute__((ext_vector_type(4)));
typedef unsigned u32x4 __attribute__((ext_vector_type(4)));
typedef unsigned u32x2 __attribute__((ext_vector_type(2)));
constexpr int T = 16384, D = 1024, FF = 2816;
constexpr float EPS = 1e-6f, LOG2E = 1.4426950408889634f;
constexpr size_t MiB = 1u << 20;
constexpr size_t WS_CTL = 8 * MiB;
constexpr size_t WS_STAT = 0, WS_SGSTAT = 1 * MiB, WS_RTSS = 4 * MiB, WS_LRAGG = 5 * MiB, WS_XB = 16 * MiB;
constexpr size_t WS_W1IN = 48 * MiB, WS_W1OUT = 59 * MiB, WS_W2IN = 65 * MiB, WS_W2OUT = 76 * MiB, WS_WMIN = 82 * MiB, WS_WMOUT = 94 * MiB, WS_WAX = 100 * MiB;
constexpr size_t WS_ACT = 104 * MiB, WS_SR = 296 * MiB, WS_END = 424 * MiB;
constexpr int LDS_BYTES = 160 * 1024;

DI float bf2f(unsigned h) { return __uint_as_float(h << 16); }
DI unsigned f2bf(float f) { unsigned u = __float_as_uint(f); return (u + 0x7fffu + ((u >> 16) & 1u)) >> 16; }
DI unsigned pk2(float lo, float hi) { return f2bf(lo) | (f2bf(hi) << 16); }
DI float sigmoidf_(float y) { return __builtin_amdgcn_rcpf(1.0f + __builtin_amdgcn_exp2f(-y * LOG2E)); }
DI float gelu_tanh(float x) { return x * sigmoidf_(1.5957691216057308f * (x + 0.044715f * x * x * x)); }
DI float wave_sum(float v) {
#pragma unroll
    for (int o = 1; o < 64; o <<= 1) v += __shfl_xor(v, o);
    return v;
}
#define LDS_WAIT() asm volatile("s_waitcnt lgkmcnt(0)" ::: "memory")

struct CvItem { const float* src; const float* gain; bfu* dst; int K, N, k0, gmask; float gsc; };
DI void cv_make(CvItem& o, int item, const float* W, int K, int N, bfu* WT, int MAP, const float* gain, int gmask, float gsc) {
    const int nblk = N / 32, kb = item / nblk, nb = item % nblk; const int drow0 = 32 * nb; int scol0 = drow0;
    if (MAP == 1) { const int pn = drow0 >> 8, bj = (drow0 >> 7) & 1, j0 = drow0 & 127; scol0 = bj * (N / 2) + 128 * pn + j0; }
    if (MAP == 2 && drow0 < 2048) { const int pn = drow0 >> 8, bj = (drow0 >> 7) & 1, wc = (drow0 >> 5) & 3; scol0 = 256 * pn + 64 * wc + 32 * bj; }
    o.src = W + (size_t)(64 * kb) * N + scol0; o.gain = gain; o.dst = WT + (size_t)drow0 * K + 64 * kb; o.K = K; o.N = N; o.k0 = 64 * kb; o.gmask = gmask; o.gsc = gsc;
}
DI void cv_load(const CvItem& it, f32x4 (&v)[8], float (&g)[8], int lane) {
#pragma unroll
    for (int i = 0; i < 8; ++i) { const int r = 8 * i + (lane >> 3); v[i] = *(const f32x4*)(it.src + (size_t)r * it.N + 4 * (lane & 7)); g[i] = it.gain ? it.gain[(it.k0 + r) & it.gmask] * it.gsc : 1.0f; }
}
DI void cv_store(const CvItem& it, const f32x4 (&v)[8], const float (&g)[8], LAS float* scr, int lane) {
#pragma unroll
    for (int i = 0; i < 8; ++i) { const int r = 8 * i + (lane >> 3); LAS float* p = scr + r * 33 + 4 * (lane & 7); p[0] = v[i][0] * g[i]; p[1] = v[i][1] * g[i]; p[2] = v[i][2] * g[i]; p[3] = v[i][3] * g[i]; }
    LDS_WAIT(); asm volatile("" ::: "memory");
    const int c = lane & 7;
#pragma unroll
    for (int j = 0; j < 4; ++j) { const int n = (lane >> 3) + 8 * j; const LAS float* s = scr + (8 * c) * 33 + n;
        u32x4 o; o.x = pk2(s[0 * 33], s[1 * 33]); o.y = pk2(s[2 * 33], s[3 * 33]); o.z = pk2(s[4 * 33], s[5 * 33]); o.w = pk2(s[6 * 33], s[7 * 33]);
        *(u32x4*)(it.dst + (size_t)n * it.K + 8 * c) = o; }
    LDS_WAIT(); asm volatile("" ::: "memory");
}
template <int MT, int NT> DI void wave_mma(f32x4 (&acc)[MT][NT], const LAS bfu* A, int lda, const LAS bfu* B, int ldb, int K, int fr, int fq) {
    for (int k0 = 0; k0 < K; k0 += 32) {
        bf16x8 a[MT];
#pragma unroll
        for (int mi = 0; mi < MT; ++mi) a[mi] = *(const LAS bf16x8*)(A + (16 * mi + fr) * lda + k0 + 8 * fq);
#pragma unroll
        for (int ni = 0; ni < NT; ++ni) { const bf16x8 b = *(const LAS bf16x8*)(B + (16 * ni + fr) * ldb + k0 + 8 * fq);
#pragma unroll
            for (int mi = 0; mi < MT; ++mi) acc[mi][ni] = __builtin_amdgcn_mfma_f32_16x16x32_bf16(a[mi], b, acc[mi][ni], 0, 0, 0); }
    }
}
#define LDS_BARRIER() asm volatile("s_waitcnt lgkmcnt(0)\n\ts_barrier" ::: "memory")
template <int NIT> DI void rows_load(u32x4 (&v)[NIT], const bfu* src, size_t gp, int C8, int tid) {
#pragma unroll
    for (int k = 0; k < NIT; ++k) { const int i = tid + 512 * k, r = i / C8, c = i - r * C8; v[k] = *(const u32x4*)(src + (size_t)r * gp + c * 8); }
}
template <int NIT> DI void rows_store(LAS bfu* dst, int LS, const u32x4 (&v)[NIT], int C8, int tid) {
#pragma unroll
    for (int k = 0; k < NIT; ++k) { const int i = tid + 512 * k, r = i / C8, c = i - r * C8; *(LAS u32x4*)(dst + r * LS + c * 8) = v[k]; }
}
template <int NIT> DI void T_load(u32x4 (&v)[NIT], const bfu* src, size_t gp, int R, int tid) {
#pragma unroll
    for (int k = 0; k < NIT; ++k) { const int i = tid + 512 * k, r = i & (R - 1), c8 = i / R; v[k] = *(const u32x4*)(src + (size_t)r * gp + c8 * 8); }
}
template <int NIT> DI void T_store(LAS bfu* dst, int LS, const u32x4 (&v)[NIT], int R, int tid, bool zeta, float lg) {
#pragma unroll
    for (int k = 0; k < NIT; ++k) { const int i = tid + 512 * k, r = i & (R - 1), c8 = i / R;
        const float z = zeta ? __builtin_amdgcn_exp2f(lg * (float)(R - 1 - r)) : 1.0f;
#pragma unroll
        for (int j = 0; j < 4; ++j) { const unsigned w = v[k][j]; float lo = bf2f(w & 0xffffu), hi = bf2f(w >> 16);
            if (zeta) { lo *= z; hi *= z; dst[(c8 * 8 + 2 * j) * LS + r] = (bfu)f2bf(lo); dst[(c8 * 8 + 2 * j + 1) * LS + r] = (bfu)f2bf(hi); }
            else { dst[(c8 * 8 + 2 * j) * LS + r] = (bfu)(w & 0xffffu); dst[(c8 * 8 + 2 * j + 1) * LS + r] = (bfu)(w >> 16); } } }
}
template <int NIT> DI void stage_rows(LAS bfu* dst, int LS, const bfu* src, size_t gp, int C8, int tid) { u32x4 v[NIT]; rows_load<NIT>(v, src, gp, C8, tid); rows_store<NIT>(dst, LS, v, C8, tid); }
template <int NIT> DI void stage_T(LAS bfu* dst, int LS, const bfu* src, size_t gp, int R, int tid, bool zeta, float lg) { u32x4 v[NIT]; T_load<NIT>(v, src, gp, R, tid); T_store<NIT>(dst, LS, v, R, tid, zeta, lg); }
DI void rt_state_phase(LAS unsigned char* lds, int bx, int G, const bfu* Kb, const bfu* Vb, bfu* SR, int tid) {
    asm volatile("" : "+v"(tid));
    const int w = tid >> 6, lane = tid & 63, fr = lane & 15, fq = lane >> 4;
    LAS bfu* sKT = (LAS bfu*)lds; LAS bfu* sVT = (LAS bfu*)(lds + 69632);
    int unit = bx; if (unit >= 512) return;
    u32x4 pk[8], pv[4];
    T_load<8>(pk, Kb + (size_t)(128 * (unit >> 2)) * 1024 + 256 * (unit & 3), 1024, 128, tid);
    T_load<4>(pv, Vb + (size_t)(128 * (unit >> 2)) * 2048 + 512 * (unit & 3), 2048, 128, tid);
    for (; unit < 512; unit += G) {
        const int c = unit >> 2, h = unit & 3; const float lg = __log2f(1.0f - exp2f(-5.0f - (float)h));
        T_store<8>(sKT, 136, pk, 128, tid, true, lg);
        for (int dvs = 0; dvs < 4; ++dvs) {
            T_store<4>(sVT, 136, pv, 128, tid, false, 0.f);
            if (dvs < 3) T_load<4>(pv, Vb + (size_t)(128 * c) * 2048 + 512 * h + 128 * (dvs + 1), 2048, 128, tid);
            else if (unit + G < 512) { const int nu = unit + G; T_load<4>(pv, Vb + (size_t)(128 * (nu >> 2)) * 2048 + 512 * (nu & 3), 2048, 128, tid); T_load<8>(pk, Kb + (size_t)(128 * (nu >> 2)) * 1024 + 256 * (nu & 3), 1024, 128, tid); }
            LDS_BARRIER();
            f32x4 acc[2][8];
#pragma unroll
            for (int mi = 0; mi < 2; ++mi)
#pragma unroll
                for (int ni = 0; ni < 8; ++ni) acc[mi][ni] = (f32x4){0.f, 0.f, 0.f, 0.f};
            wave_mma<2, 8>(acc, sKT + (32 * w) * 136, 136, sVT, 136, 128, fr, fq);
            bfu* dst = SR + (size_t)unit * 131072;
#pragma unroll
            for (int mi = 0; mi < 2; ++mi)
#pragma unroll
                for (int ni = 0; ni < 8; ++ni) { u32x2 o; o.x = pk2(acc[mi][ni][0], acc[mi][ni][1]); o.y = pk2(acc[mi][ni][2], acc[mi][ni][3]);
                    *(u32x2*)(dst + (size_t)(128 * dvs + 16 * ni + fr) * 256 + 32 * w + 16 * mi + 4 * fq) = o; }
            LDS_BARRIER();
        }
    }
}
DI void rt_scan(bfu* SR, int gtid, int gthreads) {
    asm volatile("" : "+v"(gtid));
    for (int e4 = gtid; e4 < 131072; e4 += gthreads) {
        const int h = e4 >> 15; const size_t idx = (size_t)(e4 & 32767) * 4;
        const float g = exp2f(128.0f * __log2f(1.0f - exp2f(-5.0f - (float)h)));
        float r0 = 0.f, r1 = 0.f, r2 = 0.f, r3 = 0.f;
        for (int cb = 0; cb < 128; cb += 16) {
            u32x2 v[16];
#pragma unroll
            for (int k = 0; k < 16; ++k) v[k] = *(const u32x2*)(SR + (size_t)((cb + k) * 4 + h) * 131072 + idx);
#pragma unroll
            for (int k = 0; k < 16; ++k) { u32x2 o; o.x = pk2(r0, r1); o.y = pk2(r2, r3); *(u32x2*)(SR + (size_t)((cb + k) * 4 + h) * 131072 + idx) = o;
                r0 = g * r0 + bf2f(v[k].x & 0xffffu); r1 = g * r1 + bf2f(v[k].x >> 16); r2 = g * r2 + bf2f(v[k].y & 0xffffu); r3 = g * r3 + bf2f(v[k].y >> 16); }
        }
    }
}
DI void rt_chunk_unit(LAS unsigned char* lds, int unit, const bfu* Qb, const bfu* Kb, const bfu* Vb, bfu* Ob, const bfu* Gb, const bfu* SR, int tid) {
    asm volatile("" : "+v"(tid));
    const int c = unit >> 2, h = unit & 3, w = tid >> 6, lane = tid & 63, fr = lane & 15, fq = lane >> 4;
    const float lg = __log2f(1.0f - exp2f(-5.0f - (float)h));
    LAS bfu* sQ = (LAS bfu*)lds; LAS bfu* sK = (LAS bfu*)(lds + 67584); LAS bfu* sAtt = sK; LAS bfu* sVT = (LAS bfu*)(lds + 102400); LAS bfu* sR = (LAS bfu*)(lds + 119808);
    stage_rows<8>(sQ, 264, Qb + (size_t)(128 * c) * 1024 + 256 * h, 1024, 32, tid);
    stage_rows<8>(sK, 264, Kb + (size_t)(128 * c) * 1024 + 256 * h, 1024, 32, tid);
    __syncthreads();
    { f32x4 a[1][8];
#pragma unroll
      for (int ni = 0; ni < 8; ++ni) a[0][ni] = (f32x4){0.f, 0.f, 0.f, 0.f};
      wave_mma<1, 8>(a, sQ + (16 * w) * 264, 264, sK, 264, 256, fr, fq);
      __syncthreads();
#pragma unroll
      for (int ni = 0; ni < 8; ++ni)
#pragma unroll
          for (int j = 0; j < 4; ++j) { const int t = 16 * w + 4 * fq + j, s = 16 * ni + fr; const float v = (t >= s) ? a[0][ni][j] * __builtin_amdgcn_exp2f(lg * (float)(t - s)) : 0.f; sAtt[t * 136 + s] = (bfu)f2bf(v); }
    }
    float ss[4] = {0.f, 0.f, 0.f, 0.f}, xi[4];
#pragma unroll
    for (int j = 0; j < 4; ++j) xi[j] = __builtin_amdgcn_exp2f(lg * (float)(16 * w + 4 * fq + j + 1));
    u32x4 pv[2], pr[4];
    T_load<2>(pv, Vb + (size_t)(128 * c) * 2048 + 512 * h, 2048, 128, tid);
    rows_load<4>(pr, SR + (size_t)unit * 131072, 256, 32, tid);
    for (int sl = 0; sl < 8; ++sl) {
        T_store<2>(sVT, 136, pv, 128, tid, false, 0.f);
        rows_store<4>(sR, 264, pr, 32, tid);
        if (sl < 7) { T_load<2>(pv, Vb + (size_t)(128 * c) * 2048 + 512 * h + 64 * (sl + 1), 2048, 128, tid); rows_load<4>(pr, SR + (size_t)unit * 131072 + (size_t)(64 * (sl + 1)) * 256, 256, 32, tid); }
        LDS_BARRIER();
        f32x4 o[1][4];
#pragma unroll
        for (int ni = 0; ni < 4; ++ni) o[0][ni] = (f32x4){0.f, 0.f, 0.f, 0.f};
        wave_mma<1, 4>(o, sQ + (16 * w) * 264, 264, sR, 264, 256, fr, fq);
#pragma unroll
        for (int ni = 0; ni < 4; ++ni)
#pragma unroll
            for (int j = 0; j < 4; ++j) o[0][ni][j] *= xi[j];
        wave_mma<1, 4>(o, sAtt + (16 * w) * 136, 136, sVT, 136, 128, fr, fq);
#pragma unroll
        for (int ni = 0; ni < 4; ++ni)
#pragma unroll
            for (int j = 0; j < 4; ++j) { const float v = o[0][ni][j]; ss[j] += v * v; Ob[(size_t)(128 * c + 16 * w + 4 * fq + j) * 2048 + 512 * h + 64 * sl + 16 * ni + fr] = (bfu)f2bf(v); }
        LDS_BARRIER();
    }
    LAS float* sSS = (LAS float*)(lds + 67584);
#pragma unroll
    for (int j = 0; j < 4; ++j) { float s = ss[j]; s += __shfl_xor(s, 1); s += __shfl_xor(s, 2); s += __shfl_xor(s, 4); s += __shfl_xor(s, 8);
        if (fr == 0) sSS[16 * w + 4 * fq + j] = __builtin_amdgcn_rsqf(s * (1.0f / 512.0f) + EPS); }
    __syncthreads();
#pragma unroll
    for (int hb = 0; hb < 2; ++hb) { u32x4 ov[8], gv[8];
#pragma unroll
        for (int k = 0; k < 8; ++k) { const int i = tid + 512 * (8 * hb + k), t = i >> 6, c8 = i & 63; const size_t off = (size_t)(128 * c + t) * 2048 + 512 * h + 8 * c8; ov[k] = *(const u32x4*)(Ob + off); gv[k] = *(const u32x4*)(Gb + off); }
#pragma unroll
        for (int k = 0; k < 8; ++k) { const int i = tid + 512 * (8 * hb + k), t = i >> 6, c8 = i & 63; const size_t off = (size_t)(128 * c + t) * 2048 + 512 * h + 8 * c8; const float rstd = sSS[t]; u32x4 r;
#pragma unroll
            for (int j = 0; j < 4; ++j) r[j] = pk2(bf2f(ov[k][j] & 0xffffu) * rstd * bf2f(gv[k][j] & 0xffffu), bf2f(ov[k][j] >> 16) * rstd * bf2f(gv[k][j] >> 16));
            *(u32x4*)(Ob + off) = r; } }
    __syncthreads();
}
DI void rt_gate(bfu* Vb, const bfu* Gb, const float* RTSS, int gtid, int gthreads) {
    asm volatile("" : "+v"(gtid));
    for (int i = gtid; i < T * 256; i += gthreads) { const int t = i >> 8, col = (i & 255) * 8, h = col >> 9;
        const float rstd = __builtin_amdgcn_rsqf(RTSS[t * 4 + h] * (1.0f / 512.0f) + EPS);
        const u32x4 o = *(const u32x4*)(Vb + (size_t)t * 2048 + col), g = *(const u32x4*)(Gb + (size_t)t * 2048 + col); u32x4 r;
#pragma unroll
        for (int j = 0; j < 4; ++j) r[j] = pk2(bf2f(o[j] & 0xffffu) * rstd * bf2f(g[j] & 0xffffu), bf2f(o[j] >> 16) * rstd * bf2f(g[j] >> 16));
        *(u32x4*)(Vb + (size_t)t * 2048 + col) = r; }
}
DI void sg_unit(LAS unsigned char* lds, int unit, const bfu* Ub, bfu* Uo, const bfu* Vb, const float* SGSTAT, const float* w_s, const float* b_s, const float* v_gain, int tid) {
    asm volatile("" : "+v"(tid));
    const int n = unit >> 3, g = unit & 7, w = tid >> 6, lane = tid & 63, fr = lane & 15, fq = lane >> 4;
    LAS bfu* sW = (LAS bfu*)lds; LAS bfu* sVT = (LAS bfu*)(lds + 34816); LAS float* sRstd = (LAS float*)(lds + 139264); LAS bfu* sM = sVT;
    if (tid < 128) { const f32x4* p = (const f32x4*)(SGSTAT + (size_t)(128 * n + tid) * 48); float s = 0.f;
#pragma unroll
        for (int k = 0; k < 12; ++k) { const f32x4 v = p[k]; s += (v[0] + v[1]) + (v[2] + v[3]); }
        sRstd[tid] = __builtin_amdgcn_rsqf(s * (1.0f / 3072.0f) + EPS); }
    stage_T<12>(sVT, 136, Vb + (size_t)(128 * n) * 3072 + 384 * g, 3072, 128, tid, false, 0.f);
    { f32x4 wv[8];
#pragma unroll
      for (int k = 0; k < 8; ++k) wv[k] = *(const f32x4*)(w_s + (size_t)g * 16384 + 4 * (tid + 512 * k));
      __syncthreads();
#pragma unroll
      for (int k = 0; k < 8; ++k) { const int i = 4 * (tid + 512 * k), t = i >> 7, s = i & 127; u32x2 o;
          const float a0 = (s <= t) ? wv[k][0] * sRstd[s] : 0.f, a1 = (s + 1 <= t) ? wv[k][1] * sRstd[s + 1] : 0.f, a2 = (s + 2 <= t) ? wv[k][2] * sRstd[s + 2] : 0.f, a3 = (s + 3 <= t) ? wv[k][3] * sRstd[s + 3] : 0.f;
          o.x = pk2(a0, a1); o.y = pk2(a2, a3); *(LAS u32x2*)(sW + t * 136 + s) = o; } }
    __syncthreads();
    u32x4 uv[12];
#pragma unroll
    for (int k = 0; k < 12; ++k) { const int i = tid + 512 * k, t = i / 48, c8 = i - t * 48; uv[k] = *(const u32x4*)(Ub + (size_t)(128 * n + t) * 3072 + 384 * g + 8 * c8); }
    f32x4 acc[1][24];
#pragma unroll
    for (int ni = 0; ni < 24; ++ni) acc[0][ni] = (f32x4){0.f, 0.f, 0.f, 0.f};
    wave_mma<1, 24>(acc, sW + (16 * w) * 136, 136, sVT, 136, 128, fr, fq);
    float bs[4];
#pragma unroll
    for (int j = 0; j < 4; ++j) bs[j] = b_s[g * 128 + 16 * w + 4 * fq + j];
    LDS_BARRIER();
#pragma unroll
    for (int ni = 0; ni < 24; ++ni) { const int cl = 16 * ni + fr; const float gn = v_gain[384 * g + cl];
#pragma unroll
        for (int j = 0; j < 4; ++j) sM[(16 * w + 4 * fq + j) * 392 + cl] = (bfu)f2bf(acc[0][ni][j] * gn + bs[j]); }
    LDS_BARRIER();
    {
#pragma unroll
      for (int k = 0; k < 12; ++k) { const int i = tid + 512 * k, t = i / 48, c8 = i - t * 48; const u32x4 mv = *(const LAS u32x4*)(sM + t * 392 + 8 * c8); u32x4 o;
#pragma unroll
          for (int j = 0; j < 4; ++j) o[j] = pk2(bf2f(uv[k][j] & 0xffffu) * bf2f(mv[j] & 0xffffu), bf2f(uv[k][j] >> 16) * bf2f(mv[j] >> 16));
          *(u32x4*)(Uo + (size_t)(128 * n + t) * 3072 + 384 * g + 8 * c8) = o; } }
    LDS_BARRIER();
}
template <int PASS> DI void lr_unit(LAS unsigned char* lds, int unit, const bfu* __restrict__ P, const bfu* __restrict__ WAX, const float* __restrict__ conv_w, const float* __restrict__ conv_b,
                                    const float* __restrict__ b_a, const float* __restrict__ b_x, const float* __restrict__ lam, float* AGG, bfu* __restrict__ A2, bfu* __restrict__ XBUF, bfu* __restrict__ BBUF, int tid) {
    asm volatile("" : "+v"(tid));
    const int tile = unit / 12, n = unit - tile * 12, ch0 = 128 * n, w = tid >> 6, lane = tid & 63, fr = lane & 15, fq = lane >> 4;
    LAS bfu* sB = (LAS bfu*)lds; LAS bfu* sA = (LAS bfu*)(lds + 69632); LAS float* sa = (LAS float*)(lds + 87040); LAS float* sb = (LAS float*)(lds + 120064);
    LAS float* sAgg = (LAS float*)(lds + 153088); LAS float* sAgg2 = (LAS float*)(lds + 157184);
    const int ch = tid & 127, seg = tid >> 7;
    stage_rows<8>(sB, 136, WAX + (size_t)n * 32768, 128, 16, tid);
    const float cw0 = conv_w[ch0 + ch], cw1 = conv_w[1536 + ch0 + ch], cw2 = conv_w[3072 + ch0 + ch], cw3 = conv_w[4608 + ch0 + ch], cb = conv_b[ch0 + ch];
    float spv[4], bav[4], bxv[4];
#pragma unroll
    for (int ni = 0; ni < 4; ++ni) { const int c2 = 64 * (w >> 2) + 16 * ni + fr; spv[ni] = -8.0f * LOG2E * log1pf(__expf(-lam[ch0 + c2])); bav[ni] = b_a[ch0 + c2]; bxv[ni] = b_x[ch0 + c2]; }
    float carryP = 1.f, carryH = 0.f;
    if (PASS == 2) { const int lo = (tile * seg) >> 2, hi = (tile * (seg + 1)) >> 2; float Pq = 1.f, Hq = 0.f;
        for (int k = lo; k < hi; ++k) { const float2 ag = *(const float2*)(AGG + ((size_t)k * 1536 + ch0 + ch) * 2); Hq = ag.x * Hq + ag.y; Pq *= ag.x; }
        sAgg2[(seg * 128 + ch) * 2] = Pq; sAgg2[(seg * 128 + ch) * 2 + 1] = Hq;
        __syncthreads();
#pragma unroll
        for (int s = 0; s < 4; ++s) carryH = sAgg2[(s * 128 + ch) * 2] * carryH + sAgg2[(s * 128 + ch) * 2 + 1]; }
    bfu xr[19], gr[16];
#define LR_LOADS(sb) do { const int tb_ = 256 * tile + 64 * (sb) + 16 * seg; \
        _Pragma("unroll") for (int k = 0; k < 19; ++k) { const int tt = tb_ - 3 + k; xr[k] = (tt >= 0) ? P[(size_t)tt * 3072 + 1536 + ch0 + ch] : (bfu)0; } \
        if (PASS == 2) { _Pragma("unroll") for (int k = 0; k < 16; ++k) gr[k] = P[(size_t)(tb_ + k) * 3072 + ch0 + ch]; } } while (0)
    LR_LOADS(0);
    for (int sub = 0; sub < 4; ++sub) {
        const int t0 = 256 * tile + 64 * sub, tb = t0 + 16 * seg;
        { float xv[19];
#pragma unroll
          for (int k = 0; k < 19; ++k) xv[k] = bf2f(xr[k]);
#pragma unroll
          for (int k = 0; k < 16; ++k) { const float xc = cb + cw0 * xv[k] + cw1 * xv[k + 1] + cw2 * xv[k + 2] + cw3 * xv[k + 3]; sA[(16 * seg + k) * 136 + ch] = (bfu)f2bf(xc); } }
        float gt[16];
        if (PASS == 2) {
#pragma unroll
            for (int k = 0; k < 16; ++k) gt[k] = bf2f(gr[k]); }
        if (sub < 3) LR_LOADS(sub + 1);
        LDS_BARRIER();
        { const int wrow = w & 3, half = w >> 2;
          f32x4 ar[1][4], ai[1][4];
#pragma unroll
          for (int ni = 0; ni < 4; ++ni) { ar[0][ni] = (f32x4){0.f, 0.f, 0.f, 0.f}; ai[0][ni] = (f32x4){0.f, 0.f, 0.f, 0.f}; }
          wave_mma<1, 4>(ar, sA + (16 * wrow) * 136, 136, sB + (64 * half) * 136, 136, 128, fr, fq);
          wave_mma<1, 4>(ai, sA + (16 * wrow) * 136, 136, sB + (128 + 64 * half) * 136, 136, 128, fr, fq);
#pragma unroll
          for (int ni = 0; ni < 4; ++ni) { const int c2 = 64 * half + 16 * ni + fr;
#pragma unroll
              for (int j = 0; j < 4; ++j) { const int t = 16 * wrow + 4 * fq + j; const float r = sigmoidf_(ar[0][ni][j] + bav[ni]), ig = sigmoidf_(ai[0][ni][j] + bxv[ni]);
                  const float xl = r * spv[ni], a = __builtin_amdgcn_exp2f(xl), bb = __builtin_amdgcn_sqrtf(fmaxf(1.0f - a * a, 1e-12f)) * (ig * bf2f(sA[t * 136 + c2]));
                  sa[t * 129 + c2] = xl; sb[t * 129 + c2] = bb; } } }
        LDS_BARRIER();
        { float Pp = 1.f, H = 0.f;
#pragma unroll
          for (int k = 0; k < 16; ++k) { const float xl = sa[(16 * seg + k) * 129 + ch], bbv = sb[(16 * seg + k) * 129 + ch], a = __builtin_amdgcn_exp2f(xl); H = a * H + bbv; Pp *= a;
              if (PASS == 1) { XBUF[(size_t)(tb + k) * 1536 + ch0 + ch] = (bfu)f2bf(xl); BBUF[(size_t)(tb + k) * 1536 + ch0 + ch] = (bfu)f2bf(bbv); } }
          sAgg[(seg * 128 + ch) * 2] = Pp; sAgg[(seg * 128 + ch) * 2 + 1] = H; }
        LDS_BARRIER();
        if (PASS == 1) {
#pragma unroll
            for (int s = 0; s < 4; ++s) { const float p = sAgg[(s * 128 + ch) * 2], hh = sAgg[(s * 128 + ch) * 2 + 1]; carryH = p * carryH + hh; carryP *= p; }
        } else {
            float h = carryH;
            for (int s = 0; s < seg; ++s) h = sAgg[(s * 128 + ch) * 2] * h + sAgg[(s * 128 + ch) * 2 + 1];
#pragma unroll
            for (int k = 0; k < 16; ++k) { h = __builtin_amdgcn_exp2f(sa[(16 * seg + k) * 129 + ch]) * h + sb[(16 * seg + k) * 129 + ch]; A2[(size_t)(tb + k) * 1536 + ch0 + ch] = (bfu)f2bf(h * gelu_tanh(gt[k])); }
#pragma unroll
            for (int s = 0; s < 4; ++s) carryH = sAgg[(s * 128 + ch) * 2] * carryH + sAgg[(s * 128 + ch) * 2 + 1];
        }
        LDS_BARRIER();
    }
#undef LR_LOADS
    if (PASS == 1 && seg == 0) *(float2*)(AGG + ((size_t)tile * 1536 + ch0 + ch) * 2) = make_float2(carryP, carryH);
}
DI void lr_stream_unit(LAS unsigned char* lds, int unit, const bfu* __restrict__ P, const bfu* __restrict__ XBUF, const bfu* __restrict__ BBUF, const float* __restrict__ AGG, bfu* __restrict__ A2, int tid) {
    asm volatile("" : "+v"(tid));
    const int tile = unit / 12, n = unit - tile * 12, ch0 = 128 * n, ch = tid & 127, seg = tid >> 7, tb = 256 * tile + 64 * seg;
    LAS float* sAgg = (LAS float*)lds; LAS float* sAgg2 = (LAS float*)(lds + 4096);
    const unsigned base = (unsigned)tb * 1536u + (unsigned)(ch0 + ch), gbase = (unsigned)tb * 3072u + (unsigned)(ch0 + ch);
    float Pp = 1.f, H = 0.f;
    for (int hb = 0; hb < 4; ++hb) { bfu xr[16], br[16];
#pragma unroll
        for (int k = 0; k < 16; ++k) { xr[k] = XBUF[base + (unsigned)(16 * hb + k) * 1536u]; br[k] = BBUF[base + (unsigned)(16 * hb + k) * 1536u]; }
#pragma unroll
        for (int k = 0; k < 16; ++k) { const float a = __builtin_amdgcn_exp2f(bf2f(xr[k])); H = a * H + bf2f(br[k]); Pp *= a; } }
    sAgg[(seg * 128 + ch) * 2] = Pp; sAgg[(seg * 128 + ch) * 2 + 1] = H;
    { const int lo = (tile * seg) >> 2, hi = (tile * (seg + 1)) >> 2; float Pq = 1.f, Hq = 0.f;
      int k = lo;
      for (; k + 4 <= hi; k += 4) { float2 ag[4];
#pragma unroll
          for (int q = 0; q < 4; ++q) ag[q] = *(const float2*)(AGG + ((size_t)(k + q) * 1536 + ch0 + ch) * 2);
#pragma unroll
          for (int q = 0; q < 4; ++q) { Hq = ag[q].x * Hq + ag[q].y; Pq *= ag[q].x; } }
      for (; k < hi; ++k) { const float2 ag = *(const float2*)(AGG + ((size_t)k * 1536 + ch0 + ch) * 2); Hq = ag.x * Hq + ag.y; Pq *= ag.x; }
      sAgg2[(seg * 128 + ch) * 2] = Pq; sAgg2[(seg * 128 + ch) * 2 + 1] = Hq; }
    LDS_BARRIER();
    float h = 0.f;
#pragma unroll
    for (int s = 0; s < 4; ++s) h = sAgg2[(s * 128 + ch) * 2] * h + sAgg2[(s * 128 + ch) * 2 + 1];
    for (int s = 0; s < seg; ++s) h = sAgg[(s * 128 + ch) * 2] * h + sAgg[(s * 128 + ch) * 2 + 1];
    for (int hb = 0; hb < 4; ++hb) { bfu xr[16], br[16], gr[16];
#pragma unroll
        for (int k = 0; k < 16; ++k) { xr[k] = XBUF[base + (unsigned)(16 * hb + k) * 1536u]; br[k] = BBUF[base + (unsigned)(16 * hb + k) * 1536u]; gr[k] = P[gbase + (unsigned)(16 * hb + k) * 3072u]; }
#pragma unroll
        for (int k = 0; k < 16; ++k) { h = __builtin_amdgcn_exp2f(bf2f(xr[k])) * h + bf2f(br[k]); A2[base + (unsigned)(16 * hb + k) * 1536u] = (bfu)f2bf(h * gelu_tanh(bf2f(gr[k]))); } }
    LDS_BARRIER();
}
DI void da_combine(bfu* O0, const bfu* O1, const float* lamp, int gwave, int nwaves, int lane) {
    asm volatile("" : "+v"(lane));
    const float s01 = wave_sum(lamp[lane] * lamp[64 + lane]), s23 = wave_sum(lamp[128 + lane] * lamp[192 + lane]);
    const float lmb = __expf(s01) - __expf(s23) + 0.2f;
    for (int grp0 = gwave * 4 + (lane >> 4); grp0 < T * 8; grp0 += nwaves * 8) {
        size_t base[2]; u32x4 a[2], bq[2]; bool ok[2];
#pragma unroll
        for (int q = 0; q < 2; ++q) { const int grp = grp0 + q * nwaves * 4; ok[q] = grp < T * 8; const int gg = ok[q] ? grp : grp0; base[q] = (size_t)(gg >> 3) * 1024 + (gg & 7) * 128 + (lane & 15) * 8; a[q] = *(const u32x4*)(O0 + base[q]); bq[q] = *(const u32x4*)(O1 + base[q]); }
#pragma unroll
        for (int q = 0; q < 2; ++q) { float o[8], ss = 0.f;
#pragma unroll
            for (int j = 0; j < 4; ++j) { o[2 * j] = bf2f(a[q][j] & 0xffffu) - lmb * bf2f(bq[q][j] & 0xffffu); o[2 * j + 1] = bf2f(a[q][j] >> 16) - lmb * bf2f(bq[q][j] >> 16); ss += o[2 * j] * o[2 * j] + o[2 * j + 1] * o[2 * j + 1]; }
            ss += __shfl_xor(ss, 1); ss += __shfl_xor(ss, 2); ss += __shfl_xor(ss, 4); ss += __shfl_xor(ss, 8);
            const float rstd = __builtin_amdgcn_rsqf(ss * (1.0f / 128.0f) + EPS); u32x4 r;
#pragma unroll
            for (int j = 0; j < 4; ++j) r[j] = pk2(o[2 * j] * rstd, o[2 * j + 1] * rstd);
            if (ok[q]) *(u32x4*)(O0 + base[q]) = r; } }
}
struct Args { const float* in[31]; float* out; unsigned char* ws; };
#define GAS __attribute__((address_space(1)))
DI unsigned char* opq(unsigned char* p) { GAS unsigned char* g = (GAS unsigned char*)p; asm volatile("" : "+s"(g)); return (unsigned char*)g; }
#define TID_O() ({ int t_ = threadIdx.x; asm volatile("" : "+v"(t_)); t_; })
DI const float* inp(const Args& a, int i) { asm volatile("" : "+s"(i)); const GAS float* g = (const GAS float*)a.in[i]; asm volatile("" : "+s"(g)); return (const float*)g; }
#define STAT ((float*)(opq(ws) + WS_STAT))
#define SGSTAT ((float*)(opq(ws) + WS_SGSTAT))
#define RTSS ((float*)(opq(ws) + WS_RTSS))
#define LRAGG ((float*)(opq(ws) + WS_LRAGG))
#define XB ((bfu*)(opq(ws) + WS_XB))
#define W1IN ((bfu*)(opq(ws) + WS_W1IN))
#define W1OUT ((bfu*)(opq(ws) + WS_W1OUT))
#define W2IN ((bfu*)(opq(ws) + WS_W2IN))
#define W2OUT ((bfu*)(opq(ws) + WS_W2OUT))
#define WMIN ((bfu*)(opq(ws) + WS_WMIN))
#define WMOUT ((bfu*)(opq(ws) + WS_WMOUT))
#define WAX ((bfu*)(opq(ws) + WS_WAX))
#define ACT ((bfu*)(opq(ws) + WS_ACT))
#define SR ((bfu*)(opq(ws) + WS_SR))
DI void convert_weights(const Args& args, unsigned char* ws, int groups, int l, int widx, int nw, LAS float* scr, int lane_o) {
    constexpr int I_FIN = (D / 64) * (2 * FF / 32), I_FOUT = (FF / 64) * (D / 32);
    const float* wmi; const float* wmo; int NMI, KMO, MAPI = 0, gmask = 0x7fffffff; const float* gmo = nullptr; float gsc = 1.0f;
    if (l == 0) { wmi = inp(args, 8); wmo = inp(args, 13); NMI = 3072; KMO = 1024; MAPI = 2; gmo = inp(args, 12); gmask = 127; gsc = 0.8f; }
    else if (l == 1) { wmi = inp(args, 14); wmo = inp(args, 16); NMI = 6144; KMO = 2048; gmo = inp(args, 15); }
    else if (l == 2) { wmi = inp(args, 17); wmo = inp(args, 21); NMI = 6144; KMO = 3072; }
    else { wmi = inp(args, 22); wmo = inp(args, 30); NMI = 3072; KMO = 1536; }
    const int nAi = (groups & 1) ? I_FIN : 0, nAo = (groups & 1) ? I_FOUT : 0, nCi = (groups & 4) ? I_FIN : 0, nCo = (groups & 4) ? I_FOUT : 0;
    const int I_MI = (groups & 2) ? (D / 64) * (NMI / 32) : 0, I_MO = (groups & 2) ? (KMO / 64) * (D / 32) : 0, I_AX = ((groups & 2) && l == 3) ? 192 : 0;
    const int NIT = nAi + nAo + nCi + nCo + I_MI + I_MO + I_AX;
    for (int it = widx; it < NIT; it += nw) { CvItem cur; f32x4 cv[8]; float cg[8]; int r = it;
        do {
            if (r < nAi) { cv_make(cur, r, inp(args, 2) + (size_t)l * D * 2 * FF, D, 2 * FF, W1IN, 1, inp(args, 1) + l * D, 0x7fffffff, 1.0f); break; } r -= nAi;
            if (r < nCi) { cv_make(cur, r, inp(args, 6) + (size_t)l * D * 2 * FF, D, 2 * FF, W2IN, 1, inp(args, 5) + l * D, 0x7fffffff, 1.0f); break; } r -= nCi;
            if (r < nAo) { cv_make(cur, r, inp(args, 3) + (size_t)l * FF * D, FF, D, W1OUT, 0, nullptr, 0, 1.0f); break; } r -= nAo;
            if (r < nCo) { cv_make(cur, r, inp(args, 7) + (size_t)l * FF * D, FF, D, W2OUT, 0, nullptr, 0, 1.0f); break; } r -= nCo;
            if (r < I_MI) { cv_make(cur, r, wmi, D, NMI, WMIN, MAPI, inp(args, 4) + l * D, 0x7fffffff, 1.0f); break; } r -= I_MI;
            if (r < I_MO) { cv_make(cur, r, wmo, KMO, D, WMOUT, 0, gmo, gmask, gsc); break; } r -= I_MO;
            { const int nwx = r >> 3, itx = r & 7, n = nwx >> 1, which = nwx & 1;
              cv_make(cur, itx, (which ? inp(args, 27) : inp(args, 25)) + (size_t)n * 16384, 128, 128, WAX + (size_t)n * 32768 + which * 16384, 0, nullptr, 0, 1.0f); }
        } while (0);
        cv_load(cur, cv, cg, lane_o); cv_store(cur, cv, cg, scr, lane_o); }
}
#define XB_TMO      128
#define XB_XCNT(j)  (256  + 64 * (j))
#define XB_XSUB(j)  (1280 + 64 * (j))
#define XB_XGEN(j)  (2304 + 64 * (j))
#define XB_TOP      3328
#define XB_TOPGEN   3392
#define XCD_BAR_WORDS 3456
#define XB_SPIN_CAP (1u << 18)

__device__ __forceinline__ unsigned xb_ld(unsigned* p)              { return __hip_atomic_load(p, __ATOMIC_RELAXED, __HIP_MEMORY_SCOPE_AGENT); }
__device__ __forceinline__ unsigned xb_add(unsigned* p, unsigned v) { return __hip_atomic_fetch_add(p, v, __ATOMIC_RELAXED, __HIP_MEMORY_SCOPE_AGENT); }
__device__ __forceinline__ unsigned xb_xcc_id() { return (unsigned)__builtin_amdgcn_s_getreg((3 << 11) | 20) & 0xFu; }
#define XB_SPIN(cond, bar) do { unsigned _sp = 0; while (cond) { __builtin_amdgcn_s_sleep(1); \
    if ((++_sp & 255u) == 0u) { if (xb_ld(&(bar)[XB_TMO])) break; if (_sp > XB_SPIN_CAP) { atomicAdd(&(bar)[XB_TMO], 1u); break; } } } } while (0)

struct XcdBarrier {
    unsigned* bar; unsigned x;
    volatile LAS unsigned* st;
};

__device__ __forceinline__ XcdBarrier xcd_barrier_post(unsigned* bar, volatile LAS unsigned* st) {
    XcdBarrier b; b.bar = bar; b.x = xb_xcc_id(); b.st = st;
    if (threadIdx.x == 0) (void)xb_add(&bar[XB_XCNT(b.x)], 1u);
    return b;
}
__device__ __forceinline__ void xcd_barrier_complete(unsigned* bar, unsigned x, unsigned& nloc, unsigned& nx) {
    const unsigned G = gridDim.x * gridDim.y * gridDim.z;
    unsigned sum, cnt, mine, sp = 0u;
    for (;;) {
        sum = 0u; cnt = 0u; mine = 0u;
#pragma unroll
        for (unsigned j = 0; j < 16; ++j) { const unsigned c = xb_ld(&bar[XB_XCNT(j)]); sum += c; cnt += (c > 0u) ? 1u : 0u; mine = (j == x) ? c : mine; }
        if (sum == G) break;
        __builtin_amdgcn_s_sleep(1);
        if ((++sp & 255u) == 0u) { if (xb_ld(&bar[XB_TMO])) break; if (sp > XB_SPIN_CAP) { atomicAdd(&bar[XB_TMO], 1u); break; } }
    }
    nloc = mine > 0u ? mine : 1u; nx = cnt > 0u ? cnt : 1u;
}

__device__ __forceinline__ void xcd_barrier(const XcdBarrier& b) {
    asm volatile("s_waitcnt vmcnt(0)" ::: "memory");
    __syncthreads();
    if (threadIdx.x == 0) {
        unsigned* bar = b.bar;
        __builtin_amdgcn_s_waitcnt(0);
        unsigned nloc = b.st[0], nx = b.st[1];
        if (nloc == 0u) { xcd_barrier_complete(bar, b.x, nloc, nx); b.st[0] = nloc; b.st[1] = nx; }
        const unsigned old = xb_add(&bar[XB_XSUB(b.x)], 1u);
        const unsigned gen = old / nloc;
        if (old + 1u == (gen + 1u) * nloc) {
            __builtin_amdgcn_fence(__ATOMIC_RELEASE, "agent");
            asm volatile("s_waitcnt vmcnt(0)" ::: "memory");
            const unsigned og = xb_add(&bar[XB_TOP], 1u);
            const unsigned tg = og / nx;
            if (og + 1u == (tg + 1u) * nx) xb_add(&bar[XB_TOPGEN], 1u);
            else XB_SPIN(xb_ld(&bar[XB_TOPGEN]) == tg, bar);
            __builtin_amdgcn_fence(__ATOMIC_ACQUIRE, "agent");
            xb_add(&bar[XB_XGEN(b.x)], 1u);
            asm volatile("s_waitcnt vmcnt(0)" ::: "memory");
        } else {
            XB_SPIN(xb_ld(&bar[XB_XGEN(b.x)]) == gen, bar);
            __builtin_amdgcn_fence(__ATOMIC_ACQUIRE, "agent");
            asm volatile("s_waitcnt vmcnt(0)" ::: "memory");
        }
    }
    __syncthreads();
}

#ifndef REP_ATT
#define REP_ATT 1
#endif
#ifndef REP_FFO
#define REP_FFO 1
#endif
#ifndef REP_RTC
#define REP_RTC 1
#endif
#ifndef REP_SG
#define REP_SG 1
#endif
#ifndef GEMM_ALIGN
#define GEMM_ALIGN true
#endif
#ifndef GEMM_SP2
#define GEMM_SP2 true
#endif
#ifndef REP_CV
#define REP_CV 1
#endif
#ifndef REP_LR
#define REP_LR 1
#endif
#ifndef REP_RTS
#define REP_RTS 1
#endif
#ifndef REP_FFI
#define REP_FFI 1
#endif
__global__ void __launch_bounds__(512, 2) mk_fwd(Args args) {
    extern __shared__ __attribute__((aligned(16))) unsigned char lds_raw[];
    cg::grid_group grid = cg::this_grid();
    LAS unsigned char* lds = (LAS unsigned char*)lds_raw;
    const int G = gridDim.x, bx = blockIdx.x;
    volatile LAS unsigned* bst = (volatile LAS unsigned*)(lds + 163824);
    if (threadIdx.x < 2) bst[threadIdx.x] = 0u;
    if (bx == 0) for (int i = threadIdx.x; i < XCD_BAR_WORDS; i += 512) ((unsigned*)(args.ws + WS_CTL + 4096))[i] = 0u;
    __syncthreads();
    XcdBarrier xbar; xbar.bar = (unsigned*)(args.ws + WS_CTL + 4096); xbar.x = 0; xbar.st = bst;
#define GSYNC() xcd_barrier(xbar)
#define tid TID_O()
#define lane (TID_O() & 63)
#define wave __builtin_amdgcn_readfirstlane(TID_O() >> 6)
#define gwave (bx * 8 + wave)
#define nwaves (G * 8)
#define gtid (bx * 512 + TID_O())
#define gthreads (G * 512)
    unsigned char* ws = args.ws;
    float* OUT = args.out;

#pragma unroll 1
    for (int st = 0; st < 12; ++st) {
        const int l = st / 3, ph = st - 3 * l;
        if (st == 0) {
            const int lane_o = lane; const int gw_o = gwave;
            convert_weights(args, ws, 1, 0, gw_o, nwaves, (LAS float*)(lds + wave * 16384), lane_o);
            if (bx == 0 && TID_O() < 2) ((unsigned*)(opq(ws) + WS_CTL))[64 * TID_O()] = 0u;
                for (int m = gw_o; m < T; m += 2 * nwaves) {
                    const int m2 = m + nwaves; const bool two = m2 < T;
                    const f32x4* xr = (const f32x4*)(inp(args, 0) + (size_t)m * D) + lane_o; const f32x4* xr2 = (const f32x4*)(inp(args, 0) + (size_t)(two ? m2 : m) * D) + lane_o;
                    f32x4 v[4], v2[4];
#pragma unroll
                    for (int j = 0; j < 4; ++j) { v[j] = xr[64 * j]; v2[j] = xr2[64 * j]; }
                    float s = 0.f, s2 = 0.f;
                    unsigned long long* o8 = (unsigned long long*)(XB + (size_t)m * D) + lane_o; unsigned long long* o82 = (unsigned long long*)(XB + (size_t)(two ? m2 : m) * D) + lane_o;
#pragma unroll
                    for (int j = 0; j < 4; ++j) { s += (v[j][0] * v[j][0] + v[j][1] * v[j][1]) + (v[j][2] * v[j][2] + v[j][3] * v[j][3]); s2 += (v2[j][0] * v2[j][0] + v2[j][1] * v2[j][1]) + (v2[j][2] * v2[j][2] + v2[j][3] * v2[j][3]);
                        o8[64 * j] = (unsigned long long)pk2(v[j][0], v[j][1]) | ((unsigned long long)pk2(v[j][2], v[j][3]) << 32);
                        if (two) o82[64 * j] = (unsigned long long)pk2(v2[j][0], v2[j][1]) | ((unsigned long long)pk2(v2[j][2], v2[j][3]) << 32); }
                    s = wave_sum(s); s2 = wave_sum(s2);
                    if (lane_o < 16) { STAT[(size_t)m * 16 + lane_o] = (lane_o == 0) ? s : 0.f; if (two) STAT[(size_t)m2 * 16 + lane_o] = (lane_o == 0) ? s2 : 0.f; } }
            grid.sync(); xbar = xcd_barrier_post((unsigned*)(args.ws + WS_CTL + 4096), bst);
        }
        if (ph != 1) {
            bfu* H = ACT;
            for (int rep = 0; rep < REP_FFI; ++rep)
            { pg8::Gemm g{XB, ph == 0 ? W1IN : W2IN, T, 2 * FF, D}; pg8::StaticOrder S; S.init(T, 2 * FF, G, bx);
              pg8::rstd_table(lds, STAT, S, TID_O());
              pg8::EpiSwiGLU E{H, (const LAS float*)(lds + pg8::RSTD_OFF)};
              pg8::gemm_phase<pg8::EpiSwiGLU, pg8::StaticOrder, GEMM_ALIGN, GEMM_SP2>(lds, g, S, E);
              if (ph == 0 || l < 3) { const int nwg = (T / 256) * (2 * FF / 256), rounds = (nwg + G - 1) / G, nlast = nwg - (rounds - 1) * G;
                  const int grp = (ph == 0) ? (l == 0 ? 6 : 4) : 3, lay = (ph == 0) ? l : l + 1;
                  if (nlast == G) convert_weights(args, ws, grp, lay, gwave, nwaves, (LAS float*)(lds + wave * 16384), lane);
                  else if (bx >= nlast) convert_weights(args, ws, grp, lay, (bx - nlast) * 8 + wave, (G - nlast) * 8, (LAS float*)(lds + wave * 16384), lane); } }
            GSYNC();
            { pg8::Gemm g{H, ph == 0 ? W1OUT : W2OUT, T, D, FF}; pg8::StaticOrder S; S.init(T, D, G, bx);
              pg8::EpiRes E{OUT, XB, STAT, 0.5f, st == 11 ? 1 : 0};
              pg8::gemm_phase<pg8::EpiRes, pg8::StaticOrder, GEMM_ALIGN, GEMM_SP2>(lds, g, S, E); }
            GSYNC();
        } else {
            const bfu* A2 = ACT; int KMO = 1024;
#ifndef DIS_MIX
            if (l == 0) {
                bfu* Qb = ACT; bfu* Kb = ACT + (size_t)T * 1024; bfu* Vb = ACT + (size_t)2 * T * 1024; bfu* O0 = ACT + (size_t)3 * T * 1024; bfu* O1 = ACT + (size_t)4 * T * 1024;
                { pg8::Gemm g{XB, WMIN, T, 3072, D}; pg8::StaticOrder S; S.init(T, 3072, G, bx);
                  pg8::rstd_table(lds, STAT, S, TID_O());
                  pg8::EpiRoute<0> E{Qb, Kb, Vb, nullptr, (const LAS float*)(lds + pg8::RSTD_OFF), nullptr, inp(args, 9), inp(args, 10)};
                  pg8::gemm_phase<pg8::EpiRoute<0>, pg8::StaticOrder, GEMM_ALIGN, GEMM_SP2>(lds, g, S, E); }
                GSYNC();
#ifndef DIS_ATTN
                {
                    const int ln = lane; float gq = fabsf(inp(args, 9)[ln]), gk = fabsf(inp(args, 10)[ln]);
#pragma unroll
                    for (int o = 1; o < 64; o <<= 1) { gq = fmaxf(gq, __shfl_xor(gq, o)); gk = fmaxf(gk, __shfl_xor(gk, o)); }
                    const float bound = 16.0f * gq * gk + 30.0f;
                    volatile LAS unsigned* sU = (volatile LAS unsigned*)(lds + 140 * 1024);
                    for (int rep = 0; rep < REP_ATT; ++rep) {
                    unsigned* qctr = (unsigned*)(opq(ws) + WS_CTL) + 64 * rep;
                    for (;;) {
                        if (TID_O() == 0) sU[0] = atomicAdd(qctr, 1u);
                        __syncthreads();
                        const int u = (int)sU[0];
                        __syncthreads();
                        if (u >= 2048) break;
                        const int hh = 7 - (u >> 8), r = u & 255, qb = 63 - (r >> 2), mm = (r >> 1) & 1, vh = r & 1, hm = hh * 2 + mm;
                        const float slope = exp2f(-(float)(hh + 1)); const float sl2 = slope * LOG2E;
                        const int ks = qb * 256 - (int)ceilf(bound / slope); const int t0 = ks <= 0 ? 0 : ((ks >> 6) & ~1);
                        attn_body::attn_unit<8>(qb, t0, sl2, (const attn_body::bf16*)(Qb + hm * 64), (const attn_body::bf16*)(Kb + hm * 64), (const attn_body::bf16*)(Vb + hh * 128 + vh * 64),
                                                (attn_body::bf16*)((mm ? O1 : O0) + hh * 128 + vh * 64), (char*)lds_raw);
                    }
                    }
                }
#endif
                GSYNC();
                da_combine(O0, O1, inp(args, 11), gwave, nwaves, lane);
                A2 = O0; KMO = 1024;
            } else if (l == 1) {
                bfu* Qb = ACT; bfu* Kb = ACT + (size_t)T * 1024; bfu* Vb = ACT + (size_t)2 * T * 1024; bfu* Gb = ACT + (size_t)4 * T * 1024;
                { pg8::Gemm g{XB, WMIN, T, 6144, D}; pg8::StaticOrder S; S.init(T, 6144, G, bx);
                  pg8::rstd_table(lds, STAT, S, TID_O());
                  pg8::EpiRoute<1> E{Qb, Kb, Vb, Gb, (const LAS float*)(lds + pg8::RSTD_OFF), nullptr, nullptr, nullptr};
                  pg8::gemm_phase<pg8::EpiRoute<1>, pg8::StaticOrder, GEMM_ALIGN, GEMM_SP2>(lds, g, S, E); }
                GSYNC();
#ifndef DIS_RT
                rt_state_phase(lds, bx, G, Kb, Vb, SR, tid);
                GSYNC();
                rt_scan(SR, gtid, gthreads);
                GSYNC();
                for (int u = bx; u < 512; u += G) rt_chunk_unit(lds, u, Qb, Kb, Vb, Vb, Gb, SR, tid);
#endif
                A2 = Vb; KMO = 2048;
            } else if (l == 2) {
                bfu* Ub = ACT; bfu* Vb = ACT + (size_t)T * 3072;
                { pg8::Gemm g{XB, WMIN, T, 6144, D}; pg8::StaticOrder S; S.init(T, 6144, G, bx);
                  pg8::rstd_table(lds, STAT, S, TID_O());
                  pg8::EpiRoute<2> E{Ub, Vb, nullptr, nullptr, (const LAS float*)(lds + pg8::RSTD_OFF), SGSTAT, nullptr, nullptr};
                  pg8::gemm_phase<pg8::EpiRoute<2>, pg8::StaticOrder, GEMM_ALIGN, GEMM_SP2>(lds, g, S, E); }
                GSYNC();
#ifndef DIS_SG
#if REP_SG > 1
                for (int u = bx; u < 1024; u += G) sg_unit(lds, u, Ub, SR, Vb, SGSTAT, inp(args, 19), inp(args, 20), inp(args, 18), tid);
#endif
                for (int u = bx; u < 1024; u += G) sg_unit(lds, u, Ub, Ub, Vb, SGSTAT, inp(args, 19), inp(args, 20), inp(args, 18), tid);
#endif
                A2 = Ub; KMO = 3072;
            } else {
                bfu* P = ACT; bfu* A2w = ACT + (size_t)T * 3072;
                { pg8::Gemm g{XB, WMIN, T, 3072, D}; pg8::StaticOrder S; S.init(T, 3072, G, bx);
                  pg8::rstd_table(lds, STAT, S, TID_O());
                  pg8::EpiRoute<3> E{P, nullptr, nullptr, nullptr, (const LAS float*)(lds + pg8::RSTD_OFF), nullptr, nullptr, nullptr};
                  pg8::gemm_phase<pg8::EpiRoute<3>, pg8::StaticOrder, GEMM_ALIGN, GEMM_SP2>(lds, g, S, E); }
                GSYNC();
#ifndef DIS_LR
                for (int u = bx; u < 768; u += G) lr_unit<1>(lds, u, P, WAX, inp(args, 23), inp(args, 24), inp(args, 26), inp(args, 28), inp(args, 29), LRAGG, A2w, SR, SR + (size_t)T * 1536, tid);
                GSYNC();
                for (int u = bx; u < 768; u += G) lr_stream_unit(lds, u, P, SR, SR + (size_t)T * 1536, LRAGG, A2w, tid);
#endif
                A2 = A2w; KMO = 1536;
            }
#endif
            GSYNC();
            { pg8::Gemm g{A2, WMOUT, T, D, KMO}; pg8::StaticOrder S; S.init(T, D, G, bx);
              pg8::EpiRes E{OUT, XB, STAT, 1.0f, 0};
              pg8::gemm_phase<pg8::EpiRes, pg8::StaticOrder, GEMM_ALIGN, GEMM_SP2>(lds, g, S, E); }
            GSYNC();
        }
    }
}

#undef tid
#undef lane
#undef wave
#undef gwave
#undef nwaves
#undef gtid
#undef gthreads
extern "C" void kernel_launch(void* const* d_in, const int* in_sizes, int n_in, void* d_out, int out_size, void* d_ws, size_t ws_size, hipStream_t stream) {
    static int grid = 0;
    if (grid == 0) {
        if (n_in != 31 || out_size != T * D || ws_size < WS_END) { fprintf(stderr, "kernel_launch: unexpected shapes (n_in %d out %d ws %zu need %zu)\n", n_in, out_size, ws_size, (size_t)WS_END); grid = -1; return; }
        int dev = 0, cus = 0, per_cu = 0;
        (void)hipGetDevice(&dev);
        (void)hipDeviceGetAttribute(&cus, hipDeviceAttributeMultiprocessorCount, dev);
        (void)hipFuncSetAttribute((const void*)mk_fwd, hipFuncAttributeMaxDynamicSharedMemorySize, LDS_BYTES);
        (void)hipOccupancyMaxActiveBlocksPerMultiprocessor(&per_cu, (const void*)mk_fwd, 512, LDS_BYTES);
        (void)hipGetLastError();
        grid = cus;
        fprintf(stderr, "kernel_launch: grid %d (occupancy query %d per CU), ws %zu\n", grid, per_cu, ws_size);
    }
    if (grid < 0) return;
    Args a{};
    for (int i = 0; i < 31; ++i) a.in[i] = (const float*)d_in[i];
    a.out = (float*)d_out; a.ws = (unsigned char*)d_ws;
    void* kargs[] = {&a};
    hipError_t e = hipLaunchCooperativeKernel((void*)mk_fwd, dim3(grid), dim3(512), kargs, LDS_BYTES, stream);
    if (e != hipSuccess) fprintf(stderr, "kernel_launch: cooperative launch failed: %s (grid %d)\n", hipGetErrorString(e), grid);
}
```

```cpp
#include <hip/hip_runtime.h>
#include <hip/hip_cooperative_groups.h>
#include <cstdio>
#include <cstdint>
namespace cg = cooperative_groups;
namespace pg8 {
#define PG8_LAS __attribute__((address_space(3)))
typedef unsigned short bf16_t;
typedef short bf16x8 __attribute__((ext_vector_type(8)));
typedef float f32x4 __attribute__((ext_vector_type(4)));
typedef unsigned u32x4 __attribute__((ext_vector_type(4)));
constexpr int BM = 256, BK = 64, HALF = 128, HTB = HALF * BK * 2  , STAGE_BYTES = 8 * HTB, NXCD = 8, WGM = 8;

__host__ __device__ __forceinline__ int lds_byte(int r, int c) { const int st = (r >> 4) * 2 + (c >> 5), rr = r & 15, cc = c & 31, ob = rr * 64 + cc * 2; return st * 1024 + (ob ^ (((ob >> 9) & 1) << 5)); }
__host__ __device__ __forceinline__ void stage_rc(int b, int& R, int& C) { const int st = b / 1024, sb = b % 1024, swz = sb ^ (((sb >> 9) & 1) << 5); R = (st >> 1) * 16 + swz / 64; C = (st & 1) * 32 + (swz % 64) / 2; }
__host__ __device__ __forceinline__ int perm32(int rho) { const int n = rho >> 4, i = rho & 15; return 8 * (i >> 2) + 4 * n + (i & 3); }

struct Unit { int pm, pn, slot; };
struct Gemm { const bf16_t* A; const bf16_t* Bt; int M, N, K; };

struct StaticOrder {
    int nM, nN, nwg, G, c;
    __host__ __device__ void init(int M, int N, int G_, int c_) { nM = M / BM; nN = N / BM; nwg = nM * nN; G = G_; c = c_; }
    __host__ __device__ bool next(int i, Unit& u) const {
        const long L = (long)i * G + c; if (L >= nwg) return false;
        int wgid = (int)L; { const int q = nwg / NXCD, r = nwg % NXCD, xcd = wgid % NXCD, off = wgid / NXCD; wgid = (xcd < r ? xcd * (q + 1) : r * (q + 1) + (xcd - r) * q) + off; }
        const int nig = WGM * nN, gid = wgid / nig, fm = gid * WGM, gsz = (nM - fm) < WGM ? (nM - fm) : WGM;
        u.pm = fm + ((wgid % nig) % gsz); u.pn = (wgid % nig) / gsz; u.slot = i; return true;
    }
    __device__ __forceinline__ void a_ready(const Unit&) const {}
    __device__ __forceinline__ void done(const Unit&) const {}
};
__device__ __forceinline__ unsigned cvt_pk_bf16(float lo, float hi) { unsigned r; asm volatile("v_cvt_pk_bf16_f32 %0, %1, %2" : "=v"(r) : "v"(lo), "v"(hi)); return r; }
typedef float f32x2 __attribute__((ext_vector_type(2)));
__device__ __forceinline__ f32x2 gelu_pk(f32x2 v) {
    const f32x2 av = __builtin_elementwise_abs(v), d = av * 0.2316418882f + 1.0f;
    f32x2 t; t.x = __builtin_amdgcn_rcpf(d.x); t.y = __builtin_amdgcn_rcpf(d.y);
    f32x2 q = t * 0.5307027145f + (-0.7265760135f); q = q * t + 0.7107068705f; q = q * t + (-0.142248368f); q = q * t + 0.127414796f; q = q * t;
    const f32x2 s = (v * v) * (-0.72134752044f);
    f32x2 e; e.x = __builtin_amdgcn_exp2f(s.x); e.y = __builtin_amdgcn_exp2f(s.y);
    const f32x2 m = v * (q * e), r = v - m;
    f32x2 o; o.x = v.x < 0.f ? m.x : r.x; o.y = v.y < 0.f ? m.y : r.y; return o;
}
constexpr float RMS_EPS = 1e-6f;
constexpr float LOG2E = 1.4426950408889634f;
typedef unsigned u32x2 __attribute__((ext_vector_type(2)));
__device__ __forceinline__ float fast_sigmoid(float y) { return __builtin_amdgcn_rcpf(1.0f + __builtin_amdgcn_exp2f(-y * LOG2E)); }
__device__ __forceinline__ float silu_f(float x) { return x * fast_sigmoid(x); }
__device__ __forceinline__ float gelu_tanh_f(float x) { return x * fast_sigmoid(1.5957691216057308f * (x + 0.044715f * x * x * x)); }
__device__ __forceinline__ float row_sumsq16(const float* p16) { const f32x4* p = (const f32x4*)p16; const f32x4 a = p[0], b = p[1], c = p[2], d = p[3];
    return (((a[0] + a[1]) + (a[2] + a[3])) + ((b[0] + b[1]) + (b[2] + b[3]))) + (((c[0] + c[1]) + (c[2] + c[3])) + ((d[0] + d[1]) + (d[2] + d[3]))); }
constexpr int RSTD_OFF = 131072;
template <class Sched> __device__ __forceinline__ void rstd_table(PG8_LAS unsigned char* lds, const float* stat, const Sched& S, int tid) {
    if (tid < 256) {
        f32x4 v[8][4]; int nu = 0; Unit u;
#pragma unroll
        for (int i = 0; i < 8; ++i) { if (S.next(i, u)) { const f32x4* p = (const f32x4*)(stat + (size_t)(u.pm * BM + tid) * 16); v[i][0] = p[0]; v[i][1] = p[1]; v[i][2] = p[2]; v[i][3] = p[3]; nu = i + 1; }
            else { v[i][0] = v[i][1] = v[i][2] = v[i][3] = (f32x4){0.f, 0.f, 0.f, 0.f}; } }
#pragma unroll
        for (int i = 0; i < 8; ++i) if (i < nu) { const f32x4 a = v[i][0], b = v[i][1], c = v[i][2], d = v[i][3];
            const float s = (((a[0] + a[1]) + (a[2] + a[3])) + ((b[0] + b[1]) + (b[2] + b[3]))) + (((c[0] + c[1]) + (c[2] + c[3])) + ((d[0] + d[1]) + (d[2] + d[3])));
            ((PG8_LAS float*)(lds + RSTD_OFF))[i * 256 + tid] = __builtin_amdgcn_rsqf(s * (1.0f / 1024.0f) + RMS_EPS); }
        for (int i = 8; S.next(i, u); ++i) ((PG8_LAS float*)(lds + RSTD_OFF))[i * 256 + tid] = __builtin_amdgcn_rsqf(row_sumsq16(stat + (size_t)(u.pm * BM + tid) * 16) * (1.0f / 1024.0f) + RMS_EPS);
    }
    __syncthreads();
}
__device__ __forceinline__ void load_rstd(const PG8_LAS float* tab, const Unit& u, int wr, int fr, float (&rs)[2][4]) {
#pragma unroll
    for (int ai = 0; ai < 2; ++ai)
#pragma unroll
        for (int m = 0; m < 4; ++m) rs[ai][m] = tab[u.slot * 256 + ai * HALF + wr * 64 + m * 16 + fr];
}
struct EpiSwiGLU {
    static constexpr bool PERM = true, AFTER_DRAIN = false;
    bf16_t* H; const PG8_LAS float* tab;
    __device__ __forceinline__ void operator()(const f32x4 (&acc)[2][2][4][2], const Unit& u, int wr, int wc, int fr, int fq) const {
        const int row0 = u.pm * BM + wr * 64 + fr, col0 = u.pn * HALF + wc * 32 + 8 * fq;
        float rs[2][4]; load_rstd(tab, u, wr, fr, rs);
#pragma unroll
        for (int ai = 0; ai < 2; ++ai)
#pragma unroll
            for (int m = 0; m < 4; ++m) { const float r = rs[ai][m]; float h[8];
#pragma unroll
                for (int n = 0; n < 2; ++n)
#pragma unroll
                    for (int e = 0; e < 4; ++e) { const float a = acc[ai][0][m][n][e] * r, b = acc[ai][1][m][n][e] * r; h[4 * n + e] = silu_f(a) * b; }
                u32x4 w; w.x = cvt_pk_bf16(h[0], h[1]); w.y = cvt_pk_bf16(h[2], h[3]); w.z = cvt_pk_bf16(h[4], h[5]); w.w = cvt_pk_bf16(h[6], h[7]);
                *(u32x4*)(H + (size_t)(row0 + ai * HALF + m * 16) * 2816 + col0) = w; }
    }
};
struct EpiRes {
    static constexpr bool PERM = false, AFTER_DRAIN = false;
    float* out; bf16_t* xb; float* stat; float alpha; int fin;
    __device__ __forceinline__ void operator()(const f32x4 (&acc)[2][2][4][2], const Unit& u, int wr, int wc, int fr, int fq) const {
        const int row0 = u.pm * BM + wr * 64 + fr, col0 = u.pn * BM + wc * 32 + 4 * fq;
#pragma unroll
        for (int ai = 0; ai < 2; ++ai)
#pragma unroll
            for (int m = 0; m < 4; ++m) { const int row = row0 + ai * HALF + m * 16; const size_t off = (size_t)row * 1024 + col0; float ss = 0.f;
                u32x2 bs[2][2];
#pragma unroll
                for (int bj = 0; bj < 2; ++bj)
#pragma unroll
                    for (int n = 0; n < 2; ++n) bs[bj][n] = *(const u32x2*)(xb + off + bj * HALF + n * 16);
#pragma unroll
                for (int bj = 0; bj < 2; ++bj)
#pragma unroll
                    for (int n = 0; n < 2; ++n) { f32x4 o; o[0] = __uint_as_float(bs[bj][n].x << 16); o[1] = __uint_as_float(bs[bj][n].x & 0xffff0000u); o[2] = __uint_as_float(bs[bj][n].y << 16); o[3] = __uint_as_float(bs[bj][n].y & 0xffff0000u);
                        o = o + acc[ai][bj][m][n] * alpha; ss += (o[0] * o[0] + o[1] * o[1]) + (o[2] * o[2] + o[3] * o[3]);
                        if (fin) *(f32x4*)(out + off + bj * HALF + n * 16) = o;
                        else { u32x2 w; w.x = cvt_pk_bf16(o[0], o[1]); w.y = cvt_pk_bf16(o[2], o[3]); *(u32x2*)(xb + off + bj * HALF + n * 16) = w; } }
                ss += __shfl_xor(ss, 16); ss += __shfl_xor(ss, 32);
                if (fq == 0) stat[(size_t)row * 16 + u.pn * 4 + wc] = ss; }
    }
};
template <int MODE> struct EpiRoute {
    static constexpr bool PERM = true, AFTER_DRAIN = false;
    bf16_t *d0, *d1, *d2, *d3; const PG8_LAS float* tab; float* stat2; const float *g0, *g1;
    __device__ __forceinline__ void operator()(const f32x4 (&acc)[2][2][4][2], const Unit& u, int wr, int wc, int fr, int fq) const {
        const int row0 = u.pm * BM + wr * 64 + fr; const int pn = u.pn;
        float rs[2][4]; load_rstd(tab, u, wr, fr, rs);
        if (MODE == 0 && pn < 8) {
            const bool isq = pn < 4; bf16_t* dst = isq ? d0 : d1; const float* gp = isq ? g0 : g1; const float sc = isq ? 0.125f * LOG2E : 1.0f;
            f32x4 gv[2][2];
#pragma unroll
            for (int bj = 0; bj < 2; ++bj)
#pragma unroll
                for (int n = 0; n < 2; ++n) gv[bj][n] = *(const f32x4*)(gp + 32 * bj + 8 * fq + 4 * n);
            const int colb = 256 * (pn & 3) + 64 * wc + 8 * fq;
#pragma unroll
            for (int ai = 0; ai < 2; ++ai)
#pragma unroll
                for (int m = 0; m < 4; ++m) { const float r = rs[ai][m]; f32x4 v[2][2]; float ss = 0.f;
#pragma unroll
                    for (int bj = 0; bj < 2; ++bj)
#pragma unroll
                        for (int n = 0; n < 2; ++n) { v[bj][n] = acc[ai][bj][m][n] * r; ss += (v[bj][n][0] * v[bj][n][0] + v[bj][n][1] * v[bj][n][1]) + (v[bj][n][2] * v[bj][n][2] + v[bj][n][3] * v[bj][n][3]); }
                    ss += __shfl_xor(ss, 16); ss += __shfl_xor(ss, 32);
                    const float nr = __builtin_amdgcn_rsqf(ss * (1.0f / 64.0f) + RMS_EPS) * sc;
                    bf16_t* rowp = dst + (size_t)(row0 + ai * HALF + m * 16) * 1024 + colb;
#pragma unroll
                    for (int bj = 0; bj < 2; ++bj) { const f32x4 a = v[bj][0] * gv[bj][0] * nr, b = v[bj][1] * gv[bj][1] * nr;
                        u32x4 w; w.x = cvt_pk_bf16(a[0], a[1]); w.y = cvt_pk_bf16(a[2], a[3]); w.z = cvt_pk_bf16(b[0], b[1]); w.w = cvt_pk_bf16(b[2], b[3]);
                        *(u32x4*)(rowp + 32 * bj) = w; } }
            return;
        }
        bf16_t* dst; int pitch, tile; int act = 0; float sc = 1.0f; bool sq = false;
        if (MODE == 0) { dst = d2; pitch = 1024; tile = pn - 8; }
        else if (MODE == 1) { if (pn < 4) { dst = d0; pitch = 1024; tile = pn; } else if (pn < 8) { dst = d1; pitch = 1024; tile = pn - 4; sc = 0.0625f; } else if (pn < 16) { dst = d2; pitch = 2048; tile = pn - 8; } else { dst = d3; pitch = 2048; tile = pn - 16; act = 1; } }
        else if (MODE == 2) { act = 2; pitch = 3072; if (pn < 12) { dst = d0; tile = pn; } else { dst = d1; tile = pn - 12; sq = true; } }
        else { dst = d0; pitch = 3072; tile = pn; }
        const int colb = 256 * tile + 32 * wc + 8 * fq;
#pragma unroll
        for (int ai = 0; ai < 2; ++ai)
#pragma unroll
            for (int m = 0; m < 4; ++m) { const int row = row0 + ai * HALF + m * 16; const float r = rs[ai][m] * sc; float ss = 0.f;
                bf16_t* rowp = dst + (size_t)row * pitch + colb;
#pragma unroll
                for (int bj = 0; bj < 2; ++bj) { float h[8];
#pragma unroll
                    for (int n = 0; n < 2; ++n)
#pragma unroll
                        for (int e = 0; e < 4; ++e) { float x = acc[ai][bj][m][n][e] * r; if (MODE == 1) { if (act == 1) x = silu_f(x); } if (MODE == 2) { x = gelu_tanh_f(x); ss += x * x; } h[4 * n + e] = x; }
                    u32x4 w; w.x = cvt_pk_bf16(h[0], h[1]); w.y = cvt_pk_bf16(h[2], h[3]); w.z = cvt_pk_bf16(h[4], h[5]); w.w = cvt_pk_bf16(h[6], h[7]);
                    *(u32x4*)(rowp + bj * HALF) = w; }
                if (MODE == 2) { ss += __shfl_xor(ss, 16); ss += __shfl_xor(ss, 32); if (sq && fq == 0) stat2[(size_t)row * 48 + tile * 4 + wc] = ss; } }
    }
};
template <class Epi, class Sched, bool ALIGN_EPI = false, bool SP2 = false>
__device__ __forceinline__ void gemm_phase(PG8_LAS unsigned char* lds, const Gemm g, const Sched& S, const Epi& E) {
    int tid_o = threadIdx.x; asm volatile("" : "+v"(tid_o)); const int tid = tid_o, wid = __builtin_amdgcn_readfirstlane(tid >> 6), lane = tid & 63, wr = wid >> 2, wc = wid & 3, fr = lane & 15, fq = lane >> 4;
    const int K = g.K, nt = K / BK;
    unsigned voffA[2], voffB[2];
#pragma unroll
    for (int i = 0; i < 2; ++i) { int R, C; stage_rc(tid * 16 + i * 8192, R, C); const int Rb = Epi::PERM ? ((R & ~31) + perm32(R & 31)) : R;
        voffA[i] = (unsigned)(R * K + C) * 2u; voffB[i] = (unsigned)(Rb * K + C) * 2u; }
    const size_t kstep = (size_t)(BK * 2);
    const size_t hstep = (size_t)HALF * K * 2;
    const size_t tstep = 2 * hstep;
    const unsigned ldsw = (unsigned)wid * 1024u;
    const int aoff = lds_byte(wr * 64 + fr, fq * 8), boff = lds_byte(wc * 32 + fr, fq * 8);
#define PG8_SA(b, h) (((b) * 2 + (h)) * HTB)
#define PG8_SB(b, h) ((4 + (b) * 2 + (h)) * HTB)
#define PG8_STAGE(bufoff, gbase, voff) do { _Pragma("unroll") for (int _i = 0; _i < 2; ++_i) \
        __builtin_amdgcn_global_load_lds((const unsigned*)((const char*)(gbase) + (voff)[_i]), (PG8_LAS unsigned*)(lds + (bufoff) + ldsw + _i * 8192), 16, 0, 0); } while (0)
#define PG8_LDA(dst, b, h) do { _Pragma("unroll") for (int m = 0; m < 4; ++m) _Pragma("unroll") for (int k = 0; k < 2; ++k) dst[m][k] = *(const PG8_LAS bf16x8*)(lds + PG8_SA(b, h) + aoff + m * 2048 + k * 1024); } while (0)
#define PG8_LDB(dst, b, h) do { _Pragma("unroll") for (int n = 0; n < 2; ++n) _Pragma("unroll") for (int k = 0; k < 2; ++k) dst[n][k] = *(const PG8_LAS bf16x8*)(lds + PG8_SB(b, h) + boff + n * 2048 + k * 1024); } while (0)
#define PG8_MMA(ai, bj, At, Bt) do { __builtin_amdgcn_s_setprio(1); _Pragma("unroll") for (int m = 0; m < 4; ++m) _Pragma("unroll") for (int n = 0; n < 2; ++n) _Pragma("unroll") for (int k = 0; k < 2; ++k) \
        acc[ai][bj][m][n] = __builtin_amdgcn_mfma_f32_16x16x32_bf16(Bt[n][k], At[m][k], acc[ai][bj][m][n], 0, 0, 0); __builtin_amdgcn_s_setprio(0); } while (0)
#define PG8_WAIT_V(n) asm volatile("s_waitcnt vmcnt(" #n ")" ::: "memory")
#define PG8_WAIT_L(n) asm volatile("s_waitcnt lgkmcnt(" #n ")" ::: "memory")
#define PG8_BAR __builtin_amdgcn_s_barrier()
#define PG8_SCHED __builtin_amdgcn_sched_barrier(0)
    Unit cur, nxt; int ui = 0;
    if (!S.next(0, cur)) return;
    f32x4 acc[2][2][4][2];
#pragma unroll
    for (int a = 0; a < 2; ++a)
#pragma unroll
        for (int b = 0; b < 2; ++b)
#pragma unroll
            for (int m = 0; m < 4; ++m)
#pragma unroll
                for (int n = 0; n < 2; ++n) acc[a][b][m][n] = (f32x4){0.f, 0.f, 0.f, 0.f};
    bf16x8 At[4][2], B0[2][2], B1[2][2];
    const char* cA = (const char*)g.A + (size_t)cur.pm * tstep; const char* cB = (const char*)g.Bt + (size_t)cur.pn * tstep;
    S.a_ready(cur);
    if constexpr (SP2) {
        PG8_STAGE(PG8_SB(0, 0), cB, voffB); PG8_STAGE(PG8_SB(0, 1), cB + hstep, voffB); PG8_STAGE(PG8_SA(0, 0), cA, voffA); PG8_STAGE(PG8_SA(0, 1), cA + hstep, voffA);
        if (wr == 1) PG8_BAR;
        PG8_WAIT_V(2); PG8_BAR;
        PG8_STAGE(PG8_SB(1, 0), cB + kstep, voffB); PG8_STAGE(PG8_SA(1, 0), cA + kstep, voffA); PG8_STAGE(PG8_SB(1, 1), cB + hstep + kstep, voffB);
        PG8_WAIT_V(6); PG8_BAR;
    } else {
        PG8_STAGE(PG8_SB(0, 0), cB, voffB); PG8_STAGE(PG8_SA(0, 0), cA, voffA); PG8_STAGE(PG8_SB(0, 1), cB + hstep, voffB); PG8_STAGE(PG8_SA(0, 1), cA + hstep, voffA);
        if (wr == 1) PG8_BAR;
        PG8_WAIT_V(4); PG8_BAR;
        PG8_STAGE(PG8_SB(1, 0), cB + kstep, voffB); PG8_STAGE(PG8_SA(1, 0), cA + kstep, voffA); PG8_STAGE(PG8_SB(1, 1), cB + hstep + kstep, voffB);
        PG8_WAIT_V(6); PG8_BAR;
    }
    for (;;) {
        const bool has_next = S.next(ui + 1, nxt);
        const char* nA = has_next ? (const char*)g.A + (size_t)nxt.pm * tstep : cA; const char* nB = has_next ? (const char*)g.Bt + (size_t)nxt.pn * tstep : cB;
        for (int t = 0; t < nt; t += 2) {
            const bool last = (t == nt - 2);
            const char* a1 = cA + (size_t)(t + 1) * kstep;
            const char* a2 = last ? nA : cA + (size_t)(t + 2) * kstep; const char* b2 = last ? nB : cB + (size_t)(t + 2) * kstep;
            const char* a3 = a2 + kstep; const char* b3 = b2 + kstep;
            if (last && has_next) S.a_ready(nxt);
            if constexpr (SP2) {
            PG8_LDB(B0, 0, 0); PG8_LDB(B1, 0, 1); PG8_SCHED; PG8_LDA(At, 0, 0); PG8_STAGE(PG8_SA(1, 1), a1 + hstep, voffA);
            PG8_WAIT_V(8); PG8_WAIT_L(0); PG8_BAR; PG8_MMA(0, 0, At, B0); PG8_MMA(0, 1, At, B1); PG8_BAR; PG8_SCHED;
            PG8_LDA(At, 0, 1); PG8_STAGE(PG8_SB(0, 0), b2, voffB); PG8_STAGE(PG8_SB(0, 1), b2 + hstep, voffB); PG8_STAGE(PG8_SA(0, 0), a2, voffA);
            PG8_WAIT_V(8); PG8_WAIT_L(0); PG8_BAR; PG8_MMA(1, 0, At, B0); PG8_MMA(1, 1, At, B1); PG8_BAR; PG8_SCHED;
            PG8_LDB(B0, 1, 0); PG8_LDB(B1, 1, 1); PG8_SCHED; PG8_LDA(At, 1, 0); PG8_STAGE(PG8_SA(0, 1), a2 + hstep, voffA);
            PG8_WAIT_V(8); PG8_WAIT_L(0); PG8_BAR; PG8_MMA(0, 0, At, B0); PG8_MMA(0, 1, At, B1); PG8_BAR; PG8_SCHED;
            PG8_LDA(At, 1, 1); PG8_STAGE(PG8_SB(1, 0), b3, voffB); PG8_STAGE(PG8_SB(1, 1), b3 + hstep, voffB); PG8_STAGE(PG8_SA(1, 0), a3, voffA);
            PG8_WAIT_V(8); PG8_WAIT_L(0); PG8_BAR; PG8_MMA(1, 0, At, B0); PG8_MMA(1, 1, At, B1); PG8_BAR; PG8_SCHED;
            } else {
            PG8_LDB(B0, 0, 0); PG8_SCHED; PG8_LDA(At, 0, 0); PG8_STAGE(PG8_SA(1, 1), a1 + hstep, voffA);
            PG8_WAIT_L(8); PG8_BAR; PG8_WAIT_L(0); PG8_MMA(0, 0, At, B0); PG8_BAR; PG8_SCHED;
            PG8_LDB(B1, 0, 1); PG8_STAGE(PG8_SB(0, 0), b2, voffB);
            PG8_BAR; PG8_WAIT_L(0); PG8_MMA(0, 1, At, B1); PG8_BAR;
            PG8_LDA(At, 0, 1); PG8_STAGE(PG8_SA(0, 0), a2, voffA);
            PG8_BAR; PG8_WAIT_L(0); PG8_MMA(1, 0, At, B0); PG8_BAR; PG8_SCHED;
            PG8_STAGE(PG8_SB(0, 1), b2 + hstep, voffB);
            PG8_WAIT_V(6); PG8_BAR; PG8_MMA(1, 1, At, B1); PG8_BAR;
            PG8_LDB(B0, 1, 0); PG8_SCHED; PG8_LDA(At, 1, 0); PG8_STAGE(PG8_SA(0, 1), a2 + hstep, voffA);
            PG8_WAIT_L(8); PG8_BAR; PG8_WAIT_L(0); PG8_MMA(0, 0, At, B0); PG8_BAR; PG8_SCHED;
            PG8_LDB(B1, 1, 1); PG8_STAGE(PG8_SB(1, 0), b3, voffB);
            PG8_BAR; PG8_WAIT_L(0); PG8_MMA(0, 1, At, B1); PG8_BAR;
            PG8_LDA(At, 1, 1); PG8_STAGE(PG8_SA(1, 0), a3, voffA);
            PG8_BAR; PG8_WAIT_L(0); PG8_MMA(1, 0, At, B0); PG8_BAR; PG8_SCHED;
            PG8_STAGE(PG8_SB(1, 1), b3 + hstep, voffB);
            PG8_WAIT_V(6); PG8_BAR; PG8_MMA(1, 1, At, B1); PG8_BAR;
            }
        }
        if constexpr (ALIGN_EPI) { if (wr == 0) PG8_BAR; }
        if constexpr (!Epi::AFTER_DRAIN) { E(acc, cur, wr, wc, fr, fq); S.done(cur); }
        if (!has_next) break;
#pragma unroll
        for (int a = 0; a < 2; ++a)
#pragma unroll
            for (int b = 0; b < 2; ++b)
#pragma unroll
                for (int m = 0; m < 4; ++m)
#pragma unroll
                    for (int n = 0; n < 2; ++n) acc[a][b][m][n] = (f32x4){0.f, 0.f, 0.f, 0.f};
        cur = nxt; cA = nA; cB = nB; ++ui;
        if constexpr (ALIGN_EPI) { if (wr == 1) PG8_BAR; }
    }
    PG8_WAIT_V(0);
    if constexpr (!ALIGN_EPI) { if (wr == 0) PG8_BAR; }
    PG8_BAR;
    if constexpr (Epi::AFTER_DRAIN) { E.fused(acc, cur, wr, wc, fr, fq, lds, wid, lane); S.done(cur); }
#undef PG8_SA
#undef PG8_SB
#undef PG8_STAGE
#undef PG8_LDA
#undef PG8_LDB
#undef PG8_MMA
#undef PG8_WAIT_V
#undef PG8_WAIT_L
#undef PG8_BAR
#undef PG8_SCHED
}
}
#include <hip/hip_bf16.h>
#include <cmath>
namespace attn_body {
using bf16=__hip_bfloat16;
using bf16x8=__attribute__((ext_vector_type(8)))short;
using s16x4=__attribute__((ext_vector_type(4)))short;
using f32x16=__attribute__((ext_vector_type(16)))float;
using u32x4=__attribute__((ext_vector_type(4)))unsigned;
constexpr int SEQ=16384,D=64,DM=1024;
constexpr int NW=8,QBLK=32,QB=QBLK*NW,KVBLK=64,NQB=SEQ/QB;
constexpr int ATTN_PITCH=DM, ATTN_UNIT_ROWS=QB;
__device__ __forceinline__ int crow(int r,int hi){return (r&3)+8*(r>>2)+4*hi;}
#define SBAR() __builtin_amdgcn_sched_barrier(0)
__device__ __forceinline__ void cmask(f32x16&p0,f32x16&p1,int jb,int qrel,int hi){
  const float NEG=-INFINITY; int kb=64*jb+4*hi;
  #pragma unroll
  for(int r=0;r<16;++r){int kv=kb+(r&3)+8*(r>>2); if(kv>qrel)p0[r]=NEG; if(kv+32>qrel)p1[r]=NEG;}
}

constexpr int NSLOT=3, SLOTB=8192;
constexpr int LDS_K=0, LDS_V=NSLOT*SLOTB, LDS_WS=NSLOT*SLOTB+NSLOT*2*SLOTB, LDS_QF=LDS_WS+NW*64*4, LDS_OST=0, LDS_BYTES=LDS_QF+NW*4096;
constexpr float C2=0.125f*1.4426950408889634f;
__device__ __forceinline__ void glds16(const void*gsrc,unsigned lds_dst){unsigned keep;
  asm volatile("s_mov_b32 %0, m0\n\ts_mov_b32 m0, %2\n\ts_nop 0\n\tglobal_load_lds_dwordx4 %1, off\n\ts_mov_b32 m0, %0":"=&s"(keep):"v"(gsrc),"s"(lds_dst):"memory");}
__device__ __forceinline__ void glds16s(const void*sbase,unsigned voff,unsigned lds_dst){unsigned keep;
  asm volatile("s_mov_b32 %0, m0\n\ts_mov_b32 m0, %3\n\ts_nop 0\n\tglobal_load_lds_dwordx4 %1, %2\n\ts_mov_b32 m0, %0":"=&s"(keep):"v"(voff),"s"(sbase),"s"(lds_dst):"memory");}
__device__ __forceinline__ float max3f(float a,float b,float c){float r;asm("v_max3_f32 %0, %1, %2, %3":"=v"(r):"v"(a),"v"(b),"v"(c));return r;}
__device__ __forceinline__ float max2f(float a,float b){float r;asm("v_max_f32_e32 %0, %1, %2":"=v"(r):"v"(a),"v"(b));return r;}
__device__ __forceinline__ float fadd_s(float a,float b){float r;asm("v_add_f32_e32 %0, %1, %2":"=v"(r):"v"(a),"v"(b));return r;}
__device__ __forceinline__ float fsub_s(float a,float b){float r;asm("v_sub_f32_e32 %0, %1, %2":"=v"(r):"v"(a),"v"(b));return r;}
typedef float f32x2_t __attribute__((ext_vector_type(2))); typedef __bf16 bf16x2_t __attribute__((ext_vector_type(2)));
__device__ __forceinline__ unsigned cvtpk_s(float lo,float hi){f32x2_t v={lo,hi};bf16x2_t b=__builtin_convertvector(v,bf16x2_t);return __builtin_bit_cast(unsigned,b);}
#define WAIT_BAR(N) asm volatile("s_waitcnt vmcnt(" #N ") lgkmcnt(0)\n\ts_barrier":::"memory")

__device__ __forceinline__ void qkt(f32x16&p0,f32x16&p1,const char*Kslot,const bf16x8*qr,const f32x16&negm,int r32,int hi){
  const char*kb=Kslot+hi*1024+r32*16;
  #pragma unroll
  for(int d0=0;d0<4;++d0){
    const bf16x8 b0=*reinterpret_cast<const bf16x8*>(kb+d0*2048);
    const bf16x8 b1=*reinterpret_cast<const bf16x8*>(kb+d0*2048+512);
    if(d0==0){p0=__builtin_amdgcn_mfma_f32_32x32x16_bf16(b0,qr[0],negm,0,0,0);p1=__builtin_amdgcn_mfma_f32_32x32x16_bf16(b1,qr[0],negm,0,0,0);}
    else{p0=__builtin_amdgcn_mfma_f32_32x32x16_bf16(b0,qr[d0],p0,0,0,0);p1=__builtin_amdgcn_mfma_f32_32x32x16_bf16(b1,qr[d0],p1,0,0,0);}}
}
typedef __attribute__((address_space(3))) const char* lds_cptr;
typedef short v4i16_t __attribute__((ext_vector_type(4)));
__device__ __forceinline__ void kload8(bf16x8*kf,lds_cptr kp){
  kf[0]=*(const __attribute__((address_space(3))) bf16x8*)(kp);      kf[1]=*(const __attribute__((address_space(3))) bf16x8*)(kp+512);
  kf[2]=*(const __attribute__((address_space(3))) bf16x8*)(kp+2048); kf[3]=*(const __attribute__((address_space(3))) bf16x8*)(kp+2560);
  kf[4]=*(const __attribute__((address_space(3))) bf16x8*)(kp+4096); kf[5]=*(const __attribute__((address_space(3))) bf16x8*)(kp+4608);
  kf[6]=*(const __attribute__((address_space(3))) bf16x8*)(kp+6144); kf[7]=*(const __attribute__((address_space(3))) bf16x8*)(kp+6656);
}
__device__ __forceinline__ void kload2(bf16x8*kf,lds_cptr kp,int j){ kf[2*j]=*(const __attribute__((address_space(3))) bf16x8*)(kp+j*2048); kf[2*j+1]=*(const __attribute__((address_space(3))) bf16x8*)(kp+j*2048+512); }
__device__ __forceinline__ s16x4 vtr(lds_cptr p){ return __builtin_bit_cast(s16x4,__builtin_amdgcn_ds_read_tr16_b64_v4i16((__attribute__((address_space(3))) v4i16_t*)p)); }
__device__ __forceinline__ float rowmax(const f32x16&p0,const f32x16&p1){
  float a=max3f(p0[0],p0[1],p1[0]),b=max3f(p0[2],p0[3],p1[1]);a=max3f(a,p1[2],p1[3]);
  #pragma unroll
  for(int r=4;r<16;r+=4){a=max3f(a,p0[r],p0[r+1]);b=max3f(b,p0[r+2],p0[r+3]);a=max3f(a,p1[r],p1[r+1]);b=max3f(b,p1[r+2],p1[r+3]);}
  const float m=max2f(a,b);
  auto rr=__builtin_amdgcn_permlane32_swap(__float_as_uint(m),__float_as_uint(m),false,false);
  return max2f(__uint_as_float(rr[0]),__uint_as_float(rr[1]));
}
__device__ __forceinline__ void pv(f32x16*o,int vb,bf16x8 pa0,bf16x8 pa1,bf16x8 pa2,bf16x8 pa3){
  #pragma unroll
  for(int d0=0;d0<4;++d0){s16x4 lo[4],hi[4];
    #pragma unroll
    for(int ks=0;ks<4;++ks){
      asm volatile("ds_read_b64_tr_b16 %0,%1 offset:%c2":"=&v"(lo[ks]):"v"(vb),"i"((d0&1)*4096+(d0>>1)*8192+ks*1024):"memory");
      asm volatile("ds_read_b64_tr_b16 %0,%1 offset:%c2":"=&v"(hi[ks]):"v"(vb),"i"((d0&1)*4096+(d0>>1)*8192+ks*1024+512):"memory");}
    asm volatile("s_waitcnt lgkmcnt(0)":::"memory");SBAR();
    #define PK(k) (bf16x8){lo[k][0],lo[k][1],lo[k][2],lo[k][3],hi[k][0],hi[k][1],hi[k][2],hi[k][3]}
    o[d0]=__builtin_amdgcn_mfma_f32_32x32x16_bf16(pa0,PK(0),o[d0],0,0,0);
    o[d0]=__builtin_amdgcn_mfma_f32_32x32x16_bf16(pa1,PK(1),o[d0],0,0,0);
    o[d0]=__builtin_amdgcn_mfma_f32_32x32x16_bf16(pa2,PK(2),o[d0],0,0,0);
    o[d0]=__builtin_amdgcn_mfma_f32_32x32x16_bf16(pa3,PK(3),o[d0],0,0,0);
    #undef PK
  }
}

#ifndef ATTN_STORE16
#define ATTN_STORE16(p,v) (*(u32x4*)(p)=(v))
#endif
template<int THRL> __device__ __forceinline__ void attn_unit(int qb,int t0,float sl2,const bf16*Qh,const bf16*__restrict__ Kh0,const bf16*__restrict__ Vh0,bf16*Oh,char*shm){
  int tid_o=threadIdx.x; asm volatile("":"+v"(tid_o)); const int tid=tid_o,lane=tid&63,r32=lane&31,hi=lane>>5; const int wid=__builtin_amdgcn_readfirstlane(tid>>6);
  const int q0=qb*QB;
  const bf16*Qw=Qh+(long)(q0+wid*QBLK)*DM;
  const bf16*Kh=Kh0+(long)t0*KVBLK*DM,*Vh=Vh0+(long)t0*KVBLK*DM;
  const unsigned lds0=(unsigned)(uintptr_t)shm;
  float*wsf=(float*)(shm+LDS_WS)+wid*64;
  const unsigned kvo=(unsigned)(lane*DM+wid*8)*2u;
  const unsigned vvo=(unsigned)((16*(wid&3)+(lane>>2))*DM+(wid>>2)*32+(lane&3)*8)*2u;
  const unsigned kdst=lds0+LDS_K+wid*1024, vdst=lds0+LDS_V+wid*1024;
  #define DMA_K(t,slot) glds16s(Kh+(long)(t)*KVBLK*DM,kvo,(unsigned)__builtin_amdgcn_readfirstlane(kdst+(slot)))
  #define DMA_V(t,slot) do{ glds16s(Vh+(long)(t)*KVBLK*DM,vvo,(unsigned)__builtin_amdgcn_readfirstlane(vdst+2*(slot))); glds16s(Vh+64+(long)(t)*KVBLK*DM,vvo,(unsigned)__builtin_amdgcn_readfirstlane(vdst+2*(slot)+8192)); }while(0)
  #define VB0 ((int)(lds0+LDS_V)+((lane>>4)&1)*32+(lane&3)*8+(4*hi+((lane&15)>>2))*64)
  const char*Kbase=shm+LDS_K; bf16x8 kf[8];
  const lds_cptr shm3=(lds_cptr)shm; const lds_cptr kp0=shm3+LDS_K+hi*1024+r32*16; const lds_cptr vp0=shm3+LDS_V+((lane>>4)&1)*32+(lane&3)*8+(4*hi+((lane&15)>>2))*64;
  const int NT=(q0+QB)/KVBLK-t0;
  DMA_K(0,0);DMA_V(0,0);DMA_K(1,SLOTB);
  bf16x8 qr[4];
  #pragma unroll
  for(int d0=0;d0<4;++d0)qr[d0]=*reinterpret_cast<const bf16x8*>(&Qw[(long)r32*DM+d0*16+hi*8]);
  lds_cptr qfp=(lds_cptr)shm+LDS_QF+wid*4096+lane*16;
  #pragma unroll
  for(int d0=0;d0<4;++d0)*(__attribute__((address_space(3))) bf16x8*)(qfp+d0*1024)=qr[d0];
  asm volatile("":"+v"(qfp));
  float mhat=0.f,l_reg=0.f;f32x16 o[4];o[0]=f32x16{};o[1]=f32x16{};o[2]=f32x16{};o[3]=f32x16{};f32x16 negm=f32x16{};asm volatile("":"+v"(negm)); float nb=0.f;
  const int qrel=wid*QBLK+r32;
  const float sl32=32.f*sl2, sl64=64.f*sl2; const float bt0=sl2*(float)(64*t0+4*hi-(q0+qrel));
  #define CMASK(P0,P1,t) do{int jb_=(t)-(NT-4); if(jb_>=0)cmask(P0,P1,jb_,qrel,hi);}while(0)
  bool resc=false;
  #define START(P0,P1) do{ const float rm=rowmax(P0,P1); resc=false; \
    { const float dl=rm; mhat=fadd_s(mhat,dl); \
      _Pragma("unroll") for(int r=0;r<16;++r){P0[r]=fsub_s(P0[r],dl);P1[r]=fsub_s(P1[r],dl);} \
      nb=bt0+sl64-mhat; } \
    _Pragma("unroll") for(int r=0;r<16;++r)P0[r]=__builtin_amdgcn_exp2f(P0[r]); }while(0)
  #define RESC() do{ if(resc){ asm volatile("s_waitcnt lgkmcnt(0)":::"memory"); \
      _Pragma("unroll") for(int d_=0;d_<4;++d_) _Pragma("unroll") for(int r=0;r<16;++r)o[d_][r]*=wsf[crow(r,hi)]; } }while(0)
  f32x16 pA0,pA1,pB0,pB1;
  int sl_prev=0,sl_cur=0,sl_next=SLOTB;
  #define ROT() do{sl_prev=sl_cur;sl_cur=sl_next;sl_next=(sl_next==(NSLOT-1)*SLOTB)?0:sl_next+SLOTB;}while(0)
  DMA_K(2,2*SLOTB);
  WAIT_BAR(4);
  qkt(pA0,pA1,Kbase,qr,negm,r32,hi);asm volatile("s_nop 15\n\ts_nop 7":"+v"(pA0),"+v"(pA1));
  _Pragma("unroll") for(int r=0;r<16;++r){const float bb=bt0+sl2*(float)((r&3)+8*(r>>2)); pA0[r]+=bb; pA1[r]+=bb+sl32;}
  CMASK(pA0,pA1,0);
  START(pA0,pA1);
  _Pragma("unroll") for(int r=0;r<16;++r)pA1[r]=__builtin_amdgcn_exp2f(pA1[r]);
  WAIT_BAR(0);
  DMA_K(3,0);DMA_V(1,SLOTB);
  ROT();
  kload8(kf,kp0+sl_cur);
  WAIT_BAR(3);
  s16x4 vlo[8],vhi[8]; u32x4 pw0,pw1,pw2,pw3;
  #define PKW(P,B) cvtpk_s(P[B],P[B+1])
  #define PAF(k) __builtin_bit_cast(bf16x8,pw##k)
  #define VFR(i) (bf16x8){vlo[i][0],vlo[i][1],vlo[i][2],vlo[i][3],vhi[i][0],vhi[i][1],vhi[i][2],vhi[i][3]}
  #define PIN(x) asm volatile("":"+v"(x))
  #define MX3(a,b,c) __builtin_fmaxf(__builtin_fmaxf((a),(b)),(c))
  #define GAPA(MF,A0,A1,A2,A3,W0,W1,PW) do{ MF; sacc+=A0; sacc+=A1; sacc+=A2; sacc+=A3; PIN(sacc); W0; W1; PIN(PW); SBAR(); }while(0)
  #define EX(v) __builtin_amdgcn_exp2f(v)
  #define GAPB(MF,X,B) do{ MF; X[B]=EX(X[B]); X[B+1]=EX(X[B+1]); X[B+2]=EX(X[B+2]); X[B+3]=EX(X[B+3]); PIN(X); SBAR(); }while(0)
  #define VRD(i) do{ vlo[i]=vtr(vp_+(((i)>>2)*4096+((i)&3)*1024)); vhi[i]=vtr(vp_+(((i)>>2)*4096+((i)&3)*1024+512)); }while(0)
  #define VRD2(i) do{ vlo[i]=vtr(vp_+(8192+((i)>>2)*4096+((i)&3)*1024)); vhi[i]=vtr(vp_+(8192+((i)>>2)*4096+((i)&3)*1024+512)); }while(0)
  #define KRD(G,j) do{ if(G){ kload2(kf,kp0+sl_next,j); SBAR(); } }while(0)
  #define STEP(C0,C1,P0,P1,t,GK,GV,GL) do{ SBAR(); \
    const lds_cptr vp_=vp0+2*sl_prev; \
    float sacc=(P0[0]+P0[1]); \
    f32x16 tn_; _Pragma("unroll") for(int r=0;r<16;++r)tn_[r]=nb+sl2*(float)((r&3)+8*(r>>2)); \
    bf16x8 ql_[4]; _Pragma("unroll") for(int d_=0;d_<4;++d_)ql_[d_]=*(const __attribute__((address_space(3))) bf16x8*)(qfp+d_*1024); \
    GAPA(C0=__builtin_amdgcn_mfma_f32_32x32x16_bf16(kf[0],ql_[0],tn_,0,0,0), P0[2],P0[3],P0[4],P0[5],     pw0[0]=PKW(P0,0), pw0[1]=PKW(P0,2), pw0); \
    GAPA(C1=__builtin_amdgcn_mfma_f32_32x32x16_bf16(kf[1],ql_[0],tn_,0,0,0), P0[6],P0[7],P0[8],P0[9],     pw0[2]=PKW(P0,4), pw0[3]=PKW(P0,6), pw0); \
    GAPA(C0=__builtin_amdgcn_mfma_f32_32x32x16_bf16(kf[2],ql_[1],C0,0,0,0),   P0[10],P0[11],P0[12],P0[13], pw1[0]=PKW(P0,8), pw1[1]=PKW(P0,10), pw1); \
    GAPA(C1=__builtin_amdgcn_mfma_f32_32x32x16_bf16(kf[3],ql_[1],C1,0,0,0),   P0[14],P0[15],P1[0],P1[1],   pw1[2]=PKW(P0,12),pw1[3]=PKW(P0,14), pw1); \
    GAPA(C0=__builtin_amdgcn_mfma_f32_32x32x16_bf16(kf[4],ql_[2],C0,0,0,0),   P1[2],P1[3],P1[4],P1[5],     pw2[0]=PKW(P1,0), pw2[1]=PKW(P1,2), pw2); \
    GAPA(C1=__builtin_amdgcn_mfma_f32_32x32x16_bf16(kf[5],ql_[2],C1,0,0,0),   P1[6],P1[7],P1[8],P1[9],     pw2[2]=PKW(P1,4), pw2[3]=PKW(P1,6), pw2); \
    GAPA(C0=__builtin_amdgcn_mfma_f32_32x32x16_bf16(kf[6],ql_[3],C0,0,0,0),   P1[10],P1[11],P1[12],P1[13], pw3[0]=PKW(P1,8), pw3[1]=PKW(P1,10), pw3); \
    GAPA(C1=__builtin_amdgcn_mfma_f32_32x32x16_bf16(kf[7],ql_[3],C1,0,0,0),   P1[14],P1[15],0.f,0.f,       pw3[2]=PKW(P1,12),pw3[3]=PKW(P1,14), pw3); \
    l_reg+=sacc; \
    if(GK){DMA_K((t)+3,sl_cur);} if(GV){DMA_V((t)+1,sl_next);} \
    _Pragma("unroll") for(int r=0;r<16;++r){C1[r]+=sl32;} nb+=sl64; \
    CMASK(C0,C1,t); \
    { float a=MX3(C0[0],C0[1],C1[0]),b=MX3(C0[2],C0[3],C1[1]); a=MX3(a,C1[2],C1[3]); \
      _Pragma("unroll") for(int r=4;r<16;r+=4){a=MX3(a,C0[r],C0[r+1]);b=MX3(b,C0[r+2],C0[r+3]);a=MX3(a,C1[r],C1[r+1]);b=MX3(b,C1[r+2],C1[r+3]);} \
      float rm=__builtin_fmaxf(a,b); { auto rr=__builtin_amdgcn_permlane32_swap(__float_as_uint(rm),__float_as_uint(rm),false,false); rm=__builtin_fmaxf(__uint_as_float(rr[0]),__uint_as_float(rr[1])); } \
      resc=false; \
      if(__builtin_expect(__any(rm>(float)THRL),0)){ const float dl=__builtin_fmaxf(rm,0.f); mhat+=dl; \
        _Pragma("unroll") for(int r=0;r<16;++r){C0[r]-=dl;C1[r]-=dl;} \
        nb-=dl; \
        const float f=__builtin_amdgcn_exp2f(-dl); l_reg*=f; if(hi==0)wsf[r32]=f; resc=true; } } \
    SBAR(); \
    VRD(0);VRD(4);VRD(1);VRD(5); asm volatile("s_waitcnt lgkmcnt(0)":::"memory"); SBAR(); \
    GAPB(o[0]=__builtin_amdgcn_mfma_f32_32x32x16_bf16(PAF(0),VFR(0),o[0],0,0,0), C0,0); \
    GAPB(o[1]=__builtin_amdgcn_mfma_f32_32x32x16_bf16(PAF(0),VFR(4),o[1],0,0,0), C0,4); \
    KRD(GL,0); GAPB(o[0]=__builtin_amdgcn_mfma_f32_32x32x16_bf16(PAF(1),VFR(1),o[0],0,0,0), C0,8); \
    KRD(GL,1); GAPB(o[1]=__builtin_amdgcn_mfma_f32_32x32x16_bf16(PAF(1),VFR(5),o[1],0,0,0), C0,12); \
    VRD(2);VRD(6);VRD(3);VRD(7); asm volatile("s_waitcnt lgkmcnt(0)":::"memory"); SBAR(); \
    KRD(GL,2); GAPB(o[0]=__builtin_amdgcn_mfma_f32_32x32x16_bf16(PAF(2),VFR(2),o[0],0,0,0), C1,0); \
    KRD(GL,3); GAPB(o[1]=__builtin_amdgcn_mfma_f32_32x32x16_bf16(PAF(2),VFR(6),o[1],0,0,0), C1,4); \
    GAPB(o[0]=__builtin_amdgcn_mfma_f32_32x32x16_bf16(PAF(3),VFR(3),o[0],0,0,0), C1,8); \
    GAPB(o[1]=__builtin_amdgcn_mfma_f32_32x32x16_bf16(PAF(3),VFR(7),o[1],0,0,0), C1,12); \
    VRD2(0);VRD2(4);VRD2(1);VRD2(5); asm volatile("s_waitcnt lgkmcnt(0)":::"memory"); SBAR(); \
    o[2]=__builtin_amdgcn_mfma_f32_32x32x16_bf16(PAF(0),VFR(0),o[2],0,0,0); o[3]=__builtin_amdgcn_mfma_f32_32x32x16_bf16(PAF(0),VFR(4),o[3],0,0,0); \
    o[2]=__builtin_amdgcn_mfma_f32_32x32x16_bf16(PAF(1),VFR(1),o[2],0,0,0); o[3]=__builtin_amdgcn_mfma_f32_32x32x16_bf16(PAF(1),VFR(5),o[3],0,0,0); SBAR(); \
    VRD2(2);VRD2(6);VRD2(3);VRD2(7); asm volatile("s_waitcnt lgkmcnt(0)":::"memory"); SBAR(); \
    o[2]=__builtin_amdgcn_mfma_f32_32x32x16_bf16(PAF(2),VFR(2),o[2],0,0,0); o[3]=__builtin_amdgcn_mfma_f32_32x32x16_bf16(PAF(2),VFR(6),o[3],0,0,0); \
    o[2]=__builtin_amdgcn_mfma_f32_32x32x16_bf16(PAF(3),VFR(3),o[2],0,0,0); o[3]=__builtin_amdgcn_mfma_f32_32x32x16_bf16(PAF(3),VFR(7),o[3],0,0,0); SBAR(); \
    }while(0)
  int t=1;
  #undef CMASK
  #define CMASK(P0,P1,t) do{}while(0)
  for(;t+5<NT;t+=2){
    STEP(pB0,pB1,pA0,pA1,t,true,true,true);     WAIT_BAR(3); RESC(); ROT();
    STEP(pA0,pA1,pB0,pB1,t+1,true,true,true);   WAIT_BAR(3); RESC(); ROT();
  }
  #undef CMASK
  #define CMASK(P0,P1,t) do{int jb_=(t)-(NT-4); if(jb_>=0)cmask(P0,P1,jb_,qrel,hi);}while(0)
  #define ENDW(tt) do{ if((tt)+3<NT){WAIT_BAR(3);} else if((tt)+2<NT){WAIT_BAR(2);} else {WAIT_BAR(0);} }while(0)
  for(;t+1<NT;t+=2){
    STEP(pB0,pB1,pA0,pA1,t,(t+3<NT),(t+1<NT),(t+1<NT));       ENDW(t);   RESC(); ROT();
    STEP(pA0,pA1,pB0,pB1,t+1,(t+4<NT),(t+2<NT),(t+2<NT));     ENDW(t+1); RESC(); ROT();
  }
  STEP(pB0,pB1,pA0,pA1,NT-1,false,false,false); RESC();
  { float sacc=pB0[0]+pB0[1]; _Pragma("unroll") for(int r=2;r<16;++r)sacc+=pB0[r]; _Pragma("unroll") for(int r=0;r<16;++r)sacc+=pB1[r]; l_reg+=sacc;
    pw0=(u32x4){PKW(pB0,0),PKW(pB0,2),PKW(pB0,4),PKW(pB0,6)};pw1=(u32x4){PKW(pB0,8),PKW(pB0,10),PKW(pB0,12),PKW(pB0,14)};pw2=(u32x4){PKW(pB1,0),PKW(pB1,2),PKW(pB1,4),PKW(pB1,6)};pw3=(u32x4){PKW(pB1,8),PKW(pB1,10),PKW(pB1,12),PKW(pB1,14)};
    SBAR(); pv(o,VB0+2*sl_cur,PAF(0),PAF(1),PAF(2),PAF(3)); }
  #undef PKW
  #undef PAF
  #undef VFR
  #undef PIN
  #undef MX3
  #undef GAPA
  #undef GAPB
  #undef EX
  #undef VRD
  #undef VRD2
  #undef KRD
  #undef STEP
  #undef ENDW
  {auto rr=__builtin_amdgcn_permlane32_swap(__float_as_uint(l_reg),__float_as_uint(l_reg),false,false);l_reg=__uint_as_float(rr[0])+__uint_as_float(rr[1]);}
  if(hi==0)wsf[32+r32]=l_reg;asm volatile("s_waitcnt lgkmcnt(0)":::"memory");
  float rli[16];
  #pragma unroll
  for(int r=0;r<16;++r)rli[r]=__builtin_amdgcn_rcpf(wsf[32+crow(r,hi)]);
  bf16*Ow=Oh+(long)(q0+wid*QBLK)*DM;
  asm volatile("s_waitcnt lgkmcnt(0)\n\ts_barrier":::"memory");
  { bf16*stg=(bf16*)(shm+LDS_OST)+wid*4096;
    #pragma unroll
    for(int r=0;r<16;++r){const int orow=crow(r,hi);
      #pragma unroll
      for(int d0=0;d0<4;++d0)stg[orow*128+d0*32+r32]=__float2bfloat16(o[d0][r]*rli[r]);}
    asm volatile("s_waitcnt lgkmcnt(0)":::"memory");
    #pragma unroll
    for(int i=0;i<8;++i){const int row=i*4+(lane>>4),ch=lane&15; const u32x4 v=*(const u32x4*)(stg+row*128+ch*8); ATTN_STORE16(Ow+(long)row*DM+ch*8,v);} }
  asm volatile("s_waitcnt lgkmcnt(0)\n\ts_barrier":::"memory");
  #undef DMA_K
  #undef DMA_V
  #undef CMASK
  #undef START
  #undef RESC
  #undef ROT
}
constexpr int ATTN_LDS_BYTES=LDS_BYTES;
#undef SBAR
#undef WAIT_BAR
}
#define LAS __attribute__((address_space(3)))
#define DI __device__ __forceinline__
typedef unsigned short bfu;
typedef short bf16x8 __attribute__((ext_vector_type(8)));
typedef float f32x4 __attribute__((ext_vector_type(4)));
typedef unsigned u32x4 __attribute__((ext_vector_type(4)));
typedef unsigned u32x2 __attribute__((ext_vector_type(2)));
constexpr int T = 16384, D = 1024, FF = 2816;
constexpr float EPS = 1e-6f, LOG2E = 1.4426950408889634f;
constexpr size_t MiB = 1u << 20;
constexpr size_t WS_CTL = 8 * MiB;
constexpr size_t WS_STAT = 0, WS_SGSTAT = 1 * MiB, WS_RTSS = 4 * MiB, WS_LRAGG = 5 * MiB, WS_XB = 16 * MiB;
constexpr size_t WS_W1IN = 48 * MiB, WS_W1OUT = 59 * MiB, WS_W2IN = 65 * MiB, WS_W2OUT = 76 * MiB, WS_WMIN = 82 * MiB, WS_WMOUT = 94 * MiB, WS_WAX = 100 * MiB;
constexpr size_t WS_ACT = 104 * MiB, WS_SR = 296 * MiB, WS_END = 424 * MiB;
constexpr int LDS_BYTES = 160 * 1024;

DI float bf2f(unsigned h) { return __uint_as_float(h << 16); }
DI unsigned f2bf(float f) { unsigned u = __float_as_uint(f); return (u + 0x7fffu + ((u >> 16) & 1u)) >> 16; }
DI unsigned pk2(float lo, float hi) { return f2bf(lo) | (f2bf(hi) << 16); }
DI float sigmoidf_(float y) { return __builtin_amdgcn_rcpf(1.0f + __builtin_amdgcn_exp2f(-y * LOG2E)); }
DI float gelu_tanh(float x) { return x * sigmoidf_(1.5957691216057308f * (x + 0.044715f * x * x * x)); }
DI float wave_sum(float v) {
#pragma unroll
    for (int o = 1; o < 64; o <<= 1) v += __shfl_xor(v, o);
    return v;
}
#define LDS_WAIT() asm volatile("s_waitcnt lgkmcnt(0)" ::: "memory")

struct CvItem { const float* src; const float* gain; bfu* dst; int K, N, k0, gmask; float gsc; };
DI void cv_make(CvItem& o, int item, const float* W, int K, int N, bfu* WT, int MAP, const float* gain, int gmask, float gsc) {
    const int nblk = N / 32, kb = item / nblk, nb = item % nblk; const int drow0 = 32 * nb; int scol0 = drow0;
    if (MAP == 1) { const int pn = drow0 >> 8, bj = (drow0 >> 7) & 1, j0 = drow0 & 127; scol0 = bj * (N / 2) + 128 * pn + j0; }
    if (MAP == 2 && drow0 < 2048) { const int pn = drow0 >> 8, bj = (drow0 >> 7) & 1, wc = (drow0 >> 5) & 3; scol0 = 256 * pn + 64 * wc + 32 * bj; }
    o.src = W + (size_t)(64 * kb) * N + scol0; o.gain = gain; o.dst = WT + (size_t)drow0 * K + 64 * kb; o.K = K; o.N = N; o.k0 = 64 * kb; o.gmask = gmask; o.gsc = gsc;
}
DI void cv_load(const CvItem& it, f32x4 (&v)[8], float (&g)[8], int lane) {
#pragma unroll
    for (int i = 0; i < 8; ++i) { const int r = 8 * i + (lane >> 3); v[i] = *(const f32x4*)(it.src + (size_t)r * it.N + 4 * (lane & 7)); g[i] = it.gain ? it.gain[(it.k0 + r) & it.gmask] * it.gsc : 1.0f; }
}
DI void cv_store(const CvItem& it, const f32x4 (&v)[8], const float (&g)[8], LAS float* scr, int lane) {
#pragma unroll
    for (int i = 0; i < 8; ++i) { const int r = 8 * i + (lane >> 3); LAS float* p = scr + r * 33 + 4 * (lane & 7); p[0] = v[i][0] * g[i]; p[1] = v[i][1] * g[i]; p[2] = v[i][2] * g[i]; p[3] = v[i][3] * g[i]; }
    LDS_WAIT(); asm volatile("" ::: "memory");
    const int c = lane & 7;
#pragma unroll
    for (int j = 0; j < 4; ++j) { const int n = (lane >> 3) + 8 * j; const LAS float* s = scr + (8 * c) * 33 + n;
        u32x4 o; o.x = pk2(s[0 * 33], s[1 * 33]); o.y = pk2(s[2 * 33], s[3 * 33]); o.z = pk2(s[4 * 33], s[5 * 33]); o.w = pk2(s[6 * 33], s[7 * 33]);
        *(u32x4*)(it.dst + (size_t)n * it.K + 8 * c) = o; }
    LDS_WAIT(); asm volatile("" ::: "memory");
}
template <int MT, int NT> DI void wave_mma(f32x4 (&acc)[MT][NT], const LAS bfu* A, int lda, const LAS bfu* B, int ldb, int K, int fr, int fq) {
    for (int k0 = 0; k0 < K; k0 += 32) {
        bf16x8 a[MT];
#pragma unroll
        for (int mi = 0; mi < MT; ++mi) a[mi] = *(const LAS bf16x8*)(A + (16 * mi + fr) * lda + k0 + 8 * fq);
#pragma unroll
        for (int ni = 0; ni < NT; ++ni) { const bf16x8 b = *(const LAS bf16x8*)(B + (16 * ni + fr) * ldb + k0 + 8 * fq);
#pragma unroll
            for (int mi = 0; mi < MT; ++mi) acc[mi][ni] = __builtin_amdgcn_mfma_f32_16x16x32_bf16(a[mi], b, acc[mi][ni], 0, 0, 0); }
    }
}
#define LDS_BARRIER() asm volatile("s_waitcnt lgkmcnt(0)\n\ts_barrier" ::: "memory")
template <int NIT> DI void rows_load(u32x4 (&v)[NIT], const bfu* src, size_t gp, int C8, int tid) {
#pragma unroll
    for (int k = 0; k < NIT; ++k) { const int i = tid + 512 * k, r = i / C8, c = i - r * C8; v[k] = *(const u32x4*)(src + (size_t)r * gp + c * 8); }
}
template <int NIT> DI void rows_store(LAS bfu* dst, int LS, const u32x4 (&v)[NIT], int C8, int tid) {
#pragma unroll
    for (int k = 0; k < NIT; ++k) { const int i = tid + 512 * k, r = i / C8, c = i - r * C8; *(LAS u32x4*)(dst + r * LS + c * 8) = v[k]; }
}
template <int NIT> DI void T_load(u32x4 (&v)[NIT], const bfu* src, size_t gp, int R, int tid) {
#pragma unroll
    for (int k = 0; k < NIT; ++k) { const int i = tid + 512 * k, r = i & (R - 1), c8 = i / R; v[k] = *(const u32x4*)(src + (size_t)r * gp + c8 * 8); }
}
template <int NIT> DI void T_store(LAS bfu* dst, int LS, const u32x4 (&v)[NIT], int R, int tid, bool zeta, float lg) {
#pragma unroll
    for (int k = 0; k < NIT; ++k) { const int i = tid + 512 * k, r = i & (R - 1), c8 = i / R;
        const float z = zeta ? __builtin_amdgcn_exp2f(lg * (float)(R - 1 - r)) : 1.0f;
#pragma unroll
        for (int j = 0; j < 4; ++j) { const unsigned w = v[k][j]; float lo = bf2f(w & 0xffffu), hi = bf2f(w >> 16);
            if (zeta) { lo *= z; hi *= z; dst[(c8 * 8 + 2 * j) * LS + r] = (bfu)f2bf(lo); dst[(c8 * 8 + 2 * j + 1) * LS + r] = (bfu)f2bf(hi); }
            else { dst[(c8 * 8 + 2 * j) * LS + r] = (bfu)(w & 0xffffu); dst[(c8 * 8 + 2 * j + 1) * LS + r] = (bfu)(w >> 16); } } }
}
template <int NIT> DI void stage_rows(LAS bfu* dst, int LS, const bfu* src, size_t gp, int C8, int tid) { u32x4 v[NIT]; rows_load<NIT>(v, src, gp, C8, tid); rows_store<NIT>(dst, LS, v, C8, tid); }
template <int NIT> DI void stage_T(LAS bfu* dst, int LS, const bfu* src, size_t gp, int R, int tid, bool zeta, float lg) { u32x4 v[NIT]; T_load<NIT>(v, src, gp, R, tid); T_store<NIT>(dst, LS, v, R, tid, zeta, lg); }
DI void rt_state_phase(LAS unsigned char* lds, int bx, int G, const bfu* Kb, const bfu* Vb, bfu* SR, int tid) {
    asm volatile("" : "+v"(tid));
    const int w = tid >> 6, lane = tid & 63, fr = lane & 15, fq = lane >> 4;
    LAS bfu* sKT = (LAS bfu*)lds; LAS bfu* sVT = (LAS bfu*)(lds + 69632);
    int unit = bx; if (unit >= 512) return;
    u32x4 pk[8], pv[4];
    T_load<8>(pk, Kb + (size_t)(128 * (unit >> 2)) * 1024 + 256 * (unit & 3), 1024, 128, tid);
    T_load<4>(pv, Vb + (size_t)(128 * (unit >> 2)) * 2048 + 512 * (unit & 3), 2048, 128, tid);
    for (; unit < 512; unit += G) {
        const int c = unit >> 2, h = unit & 3; const float lg = __log2f(1.0f - exp2f(-5.0f - (float)h));
        T_store<8>(sKT, 136, pk, 128, tid, true, lg);
        for (int dvs = 0; dvs < 4; ++dvs) {
            T_store<4>(sVT, 136, pv, 128, tid, false, 0.f);
            if (dvs < 3) T_load<4>(pv, Vb + (size_t)(128 * c) * 2048 + 512 * h + 128 * (dvs + 1), 2048, 128, tid);
            else if (unit + G < 512) { const int nu = unit + G; T_load<4>(pv, Vb + (size_t)(128 * (nu >> 2)) * 2048 + 512 * (nu & 3), 2048, 128, tid); T_load<8>(pk, Kb + (size_t)(128 * (nu >> 2)) * 1024 + 256 * (nu & 3), 1024, 128, tid); }
            LDS_BARRIER();
            f32x4 acc[2][8];
#pragma unroll
            for (int mi = 0; mi < 2; ++mi)
#pragma unroll
                for (int ni = 0; ni < 8; ++ni) acc[mi][ni] = (f32x4){0.f, 0.f, 0.f, 0.f};
            wave_mma<2, 8>(acc, sKT + (32 * w) * 136, 136, sVT, 136, 128, fr, fq);
            bfu* dst = SR + (size_t)unit * 131072;
#pragma unroll
            for (int mi = 0; mi < 2; ++mi)
#pragma unroll
                for (int ni = 0; ni < 8; ++ni) { u32x2 o; o.x = pk2(acc[mi][ni][0], acc[mi][ni][1]); o.y = pk2(acc[mi][ni][2], acc[mi][ni][3]);
                    *(u32x2*)(dst + (size_t)(128 * dvs + 16 * ni + fr) * 256 + 32 * w + 16 * mi + 4 * fq) = o; }
            LDS_BARRIER();
        }
    }
}
DI void rt_scan(bfu* SR, int gtid, int gthreads) {
    asm volatile("" : "+v"(gtid));
    for (int e4 = gtid; e4 < 131072; e4 += gthreads) {
        const int h = e4 >> 15; const size_t idx = (size_t)(e4 & 32767) * 4;
        const float g = exp2f(128.0f * __log2f(1.0f - exp2f(-5.0f - (float)h)));
        float r0 = 0.f, r1 = 0.f, r2 = 0.f, r3 = 0.f;
        for (int cb = 0; cb < 128; cb += 16) {
            u32x2 v[16];
#pragma unroll
            for (int k = 0; k < 16; ++k) v[k] = *(const u32x2*)(SR + (size_t)((cb + k) * 4 + h) * 131072 + idx);
#pragma unroll
            for (int k = 0; k < 16; ++k) { u32x2 o; o.x = pk2(r0, r1); o.y = pk2(r2, r3); *(u32x2*)(SR + (size_t)((cb + k) * 4 + h) * 131072 + idx) = o;
                r0 = g * r0 + bf2f(v[k].x & 0xffffu); r1 = g * r1 + bf2f(v[k].x >> 16); r2 = g * r2 + bf2f(v[k].y & 0xffffu); r3 = g * r3 + bf2f(v[k].y >> 16); }
        }
    }
}
DI void rt_chunk_unit(LAS unsigned char* lds, int unit, const bfu* Qb, const bfu* Kb, const bfu* Vb, bfu* Ob, const bfu* Gb, const bfu* SR, int tid) {
    asm volatile("" : "+v"(tid));
    const int c = unit >> 2, h = unit & 3, w = tid >> 6, lane = tid & 63, fr = lane & 15, fq = lane >> 4;
    const float lg = __log2f(1.0f - exp2f(-5.0f - (float)h));
    LAS bfu* sQ = (LAS bfu*)lds; LAS bfu* sK = (LAS bfu*)(lds + 67584); LAS bfu* sAtt = sK; LAS bfu* sVT = (LAS bfu*)(lds + 102400); LAS bfu* sR = (LAS bfu*)(lds + 119808);
    stage_rows<8>(sQ, 264, Qb + (size_t)(128 * c) * 1024 + 256 * h, 1024, 32, tid);
    stage_rows<8>(sK, 264, Kb + (size_t)(128 * c) * 1024 + 256 * h, 1024, 32, tid);
    __syncthreads();
    { f32x4 a[1][8];
#pragma unroll
      for (int ni = 0; ni < 8; ++ni) a[0][ni] = (f32x4){0.f, 0.f, 0.f, 0.f};
      wave_mma<1, 8>(a, sQ + (16 * w) * 264, 264, sK, 264, 256, fr, fq);
      __syncthreads();
#pragma unroll
      for (int ni = 0; ni < 8; ++ni)
#pragma unroll
          for (int j = 0; j < 4; ++j) { const int t = 16 * w + 4 * fq + j, s = 16 * ni + fr; const float v = (t >= s) ? a[0][ni][j] * __builtin_amdgcn_exp2f(lg * (float)(t - s)) : 0.f; sAtt[t * 136 + s] = (bfu)f2bf(v); }
    }
    float ss[4] = {0.f, 0.f, 0.f, 0.f}, xi[4];
#pragma unroll
    for (int j = 0; j < 4; ++j) xi[j] = __builtin_amdgcn_exp2f(lg * (float)(16 * w + 4 * fq + j + 1));
    u32x4 pv[2], pr[4];
    T_load<2>(pv, Vb + (size_t)(128 * c) * 2048 + 512 * h, 2048, 128, tid);
    rows_load<4>(pr, SR + (size_t)unit * 131072, 256, 32, tid);
    for (int sl = 0; sl < 8; ++sl) {
        T_store<2>(sVT, 136, pv, 128, tid, false, 0.f);
        rows_store<4>(sR, 264, pr, 32, tid);
        if (sl < 7) { T_load<2>(pv, Vb + (size_t)(128 * c) * 2048 + 512 * h + 64 * (sl + 1), 2048, 128, tid); rows_load<4>(pr, SR + (size_t)unit * 131072 + (size_t)(64 * (sl + 1)) * 256, 256, 32, tid); }
        LDS_BARRIER();
        f32x4 o[1][4];
#pragma unroll
        for (int ni = 0; ni < 4; ++ni) o[0][ni] = (f32x4){0.f, 0.f, 0.f, 0.f};
        wave_mma<1, 4>(o, sQ + (16 * w) * 264, 264, sR, 264, 256, fr, fq);
#pragma unroll
        for (int ni = 0; ni < 4; ++ni)
#pragma unroll
            for (int j = 0; j < 4; ++j) o[0][ni][j] *= xi[j];
        wave_mma<1, 4>(o, sAtt + (16 * w) * 136, 136, sVT, 136, 128, fr, fq);
#pragma unroll
        for (int ni = 0; ni < 4; ++ni)
#pragma unroll
            for (int j = 0; j < 4; ++j) { const float v = o[0][ni][j]; ss[j] += v * v; Ob[(size_t)(128 * c + 16 * w + 4 * fq + j) * 2048 + 512 * h + 64 * sl + 16 * ni + fr] = (bfu)f2bf(v); }
        LDS_BARRIER();
    }
    LAS float* sSS = (LAS float*)(lds + 67584);
#pragma unroll
    for (int j = 0; j < 4; ++j) { float s = ss[j]; s += __shfl_xor(s, 1); s += __shfl_xor(s, 2); s += __shfl_xor(s, 4); s += __shfl_xor(s, 8);
        if (fr == 0) sSS[16 * w + 4 * fq + j] = __builtin_amdgcn_rsqf(s * (1.0f / 512.0f) + EPS); }
    __syncthreads();
#pragma unroll
    for (int hb = 0; hb < 2; ++hb) { u32x4 ov[8], gv[8];
#pragma unroll
        for (int k = 0; k < 8; ++k) { const int i = tid + 512 * (8 * hb + k), t = i >> 6, c8 = i & 63; const size_t off = (size_t)(128 * c + t) * 2048 + 512 * h + 8 * c8; ov[k] = *(const u32x4*)(Ob + off); gv[k] = *(const u32x4*)(Gb + off); }
#pragma unroll
        for (int k = 0; k < 8; ++k) { const int i = tid + 512 * (8 * hb + k), t = i >> 6, c8 = i & 63; const size_t off = (size_t)(128 * c + t) * 2048 + 512 * h + 8 * c8; const float rstd = sSS[t]; u32x4 r;
#pragma unroll
            for (int j = 0; j < 4; ++j) r[j] = pk2(bf2f(ov[k][j] & 0xffffu) * rstd * bf2f(gv[k][j] & 0xffffu), bf2f(ov[k][j] >> 16) * rstd * bf2f(gv[k][j] >> 16));
            *(u32x4*)(Ob + off) = r; } }
    __syncthreads();
}
DI void rt_gate(bfu* Vb, const bfu* Gb, const float* RTSS, int gtid, int gthreads) {
    asm volatile("" : "+v"(gtid));
    for (int i = gtid; i < T * 256; i += gthreads) { const int t = i >> 8, col = (i & 255) * 8, h = col >> 9;
        const float rstd = __builtin_amdgcn_rsqf(RTSS[t * 4 + h] * (1.0f / 512.0f) + EPS);
        const u32x4 o = *(const u32x4*)(Vb + (size_t)t * 2048 + col), g = *(const u32x4*)(Gb + (size_t)t * 2048 + col); u32x4 r;
#pragma unroll
        for (int j = 0; j < 4; ++j) r[j] = pk2(bf2f(o[j] & 0xffffu) * rstd * bf2f(g[j] & 0xffffu), bf2f(o[j] >> 16) * rstd * bf2f(g[j] >> 16));
        *(u32x4*)(Vb + (size_t)t * 2048 + col) = r; }
}
DI void sg_unit(LAS unsigned char* lds, int unit, const bfu* Ub, bfu* Uo, const bfu* Vb, const float* SGSTAT, const float* w_s, const float* b_s, const float* v_gain, int tid) {
    asm volatile("" : "+v"(tid));
    const int n = unit >> 3, g = unit & 7, w = tid >> 6, lane = tid & 63, fr = lane & 15, fq = lane >> 4;
    LAS bfu* sW = (LAS bfu*)lds; LAS bfu* sVT = (LAS bfu*)(lds + 34816); LAS float* sRstd = (LAS float*)(lds + 139264); LAS bfu* sM = sVT;
    if (tid < 128) { const f32x4* p = (const f32x4*)(SGSTAT + (size_t)(128 * n + tid) * 48); float s = 0.f;
#pragma unroll
        for (int k = 0; k < 12; ++k) { const f32x4 v = p[k]; s += (v[0] + v[1]) + (v[2] + v[3]); }
        sRstd[tid] = __builtin_amdgcn_rsqf(s * (1.0f / 3072.0f) + EPS); }
    stage_T<12>(sVT, 136, Vb + (size_t)(128 * n) * 3072 + 384 * g, 3072, 128, tid, false, 0.f);
    { f32x4 wv[8];
#pragma unroll
      for (int k = 0; k < 8; ++k) wv[k] = *(const f32x4*)(w_s + (size_t)g * 16384 + 4 * (tid + 512 * k));
      __syncthreads();
#pragma unroll
      for (int k = 0; k < 8; ++k) { const int i = 4 * (tid + 512 * k), t = i >> 7, s = i & 127; u32x2 o;
          const float a0 = (s <= t) ? wv[k][0] * sRstd[s] : 0.f, a1 = (s + 1 <= t) ? wv[k][1] * sRstd[s + 1] : 0.f, a2 = (s + 2 <= t) ? wv[k][2] * sRstd[s + 2] : 0.f, a3 = (s + 3 <= t) ? wv[k][3] * sRstd[s + 3] : 0.f;
          o.x = pk2(a0, a1); o.y = pk2(a2, a3); *(LAS u32x2*)(sW + t * 136 + s) = o; } }
    __syncthreads();
    u32x4 uv[12];
#pragma unroll
    for (int k = 0; k < 12; ++k) { const int i = tid + 512 * k, t = i / 48, c8 = i - t * 48; uv[k] = *(const u32x4*)(Ub + (size_t)(128 * n + t) * 3072 + 384 * g + 8 * c8); }
    f32x4 acc[1][24];
#pragma unroll
    for (int ni = 0; ni < 24; ++ni) acc[0][ni] = (f32x4){0.f, 0.f, 0.f, 0.f};
    wave_mma<1, 24>(acc, sW + (16 * w) * 136, 136, sVT, 136, 128, fr, fq);
    float bs[4];
#pragma unroll
    for (int j = 0; j < 4; ++j) bs[j] = b_s[g * 128 + 16 * w + 4 * fq + j];
    LDS_BARRIER();
#pragma unroll
    for (int ni = 0; ni < 24; ++ni) { const int cl = 16 * ni + fr; const float gn = v_gain[384 * g + cl];
#pragma unroll
        for (int j = 0; j < 4; ++j) sM[(16 * w + 4 * fq + j) * 392 + cl] = (bfu)f2bf(acc[0][ni][j] * gn + bs[j]); }
    LDS_BARRIER();
    {
#pragma unroll
      for (int k = 0; k < 12; ++k) { const int i = tid + 512 * k, t = i / 48, c8 = i - t * 48; const u32x4 mv = *(const LAS u32x4*)(sM + t * 392 + 8 * c8); u32x4 o;
#pragma unroll
          for (int j = 0; j < 4; ++j) o[j] = pk2(bf2f(uv[k][j] & 0xffffu) * bf2f(mv[j] & 0xffffu), bf2f(uv[k][j] >> 16) * bf2f(mv[j] >> 16));
          *(u32x4*)(Uo + (size_t)(128 * n + t) * 3072 + 384 * g + 8 * c8) = o; } }
    LDS_BARRIER();
}
template <int PASS> DI void lr_unit(LAS unsigned char* lds, int unit, const bfu* __restrict__ P, const bfu* __restrict__ WAX, const float* __restrict__ conv_w, const float* __restrict__ conv_b,
                                    const float* __restrict__ b_a, const float* __restrict__ b_x, const float* __restrict__ lam, float* AGG, bfu* __restrict__ A2, bfu* __restrict__ XBUF, bfu* __restrict__ BBUF, int tid) {
    asm volatile("" : "+v"(tid));
    const int tile = unit / 12, n = unit - tile * 12, ch0 = 128 * n, w = tid >> 6, lane = tid & 63, fr = lane & 15, fq = lane >> 4;
    LAS bfu* sB = (LAS bfu*)lds; LAS bfu* sA = (LAS bfu*)(lds + 69632); LAS float* sa = (LAS float*)(lds + 87040); LAS float* sb = (LAS float*)(lds + 120064);
    LAS float* sAgg = (LAS float*)(lds + 153088); LAS float* sAgg2 = (LAS float*)(lds + 157184);
    const int ch = tid & 127, seg = tid >> 7;
    stage_rows<8>(sB, 136, WAX + (size_t)n * 32768, 128, 16, tid);
    const float cw0 = conv_w[ch0 + ch], cw1 = conv_w[1536 + ch0 + ch], cw2 = conv_w[3072 + ch0 + ch], cw3 = conv_w[4608 + ch0 + ch], cb = conv_b[ch0 + ch];
    float spv[4], bav[4], bxv[4];
#pragma unroll
    for (int ni = 0; ni < 4; ++ni) { const int c2 = 64 * (w >> 2) + 16 * ni + fr; spv[ni] = -8.0f * LOG2E * log1pf(__expf(-lam[ch0 + c2])); bav[ni] = b_a[ch0 + c2]; bxv[ni] = b_x[ch0 + c2]; }
    float carryP = 1.f, carryH = 0.f;
    if (PASS == 2) { const int lo = (tile * seg) >> 2, hi = (tile * (seg + 1)) >> 2; float Pq = 1.f, Hq = 0.f;
        for (int k = lo; k < hi; ++k) { const float2 ag = *(const float2*)(AGG + ((size_t)k * 1536 + ch0 + ch) * 2); Hq = ag.x * Hq + ag.y; Pq *= ag.x; }
        sAgg2[(seg * 128 + ch) * 2] = Pq; sAgg2[(seg * 128 + ch) * 2 + 1] = Hq;
        __syncthreads();
#pragma unroll
        for (int s = 0; s < 4; ++s) carryH = sAgg2[(s * 128 + ch) * 2] * carryH + sAgg2[(s * 128 + ch) * 2 + 1]; }
    bfu xr[19], gr[16];
#define LR_LOADS(sb) do { const int tb_ = 256 * tile + 64 * (sb) + 16 * seg; \
        _Pragma("unroll") for (int k = 0; k < 19; ++k) { const int tt = tb_ - 3 + k; xr[k] = (tt >= 0) ? P[(size_t)tt * 3072 + 1536 + ch0 + ch] : (bfu)0; } \
        if (PASS == 2) { _Pragma("unroll") for (int k = 0; k < 16; ++k) gr[k] = P[(size_t)(tb_ + k) * 3072 + ch0 + ch]; } } while (0)
    LR_LOADS(0);
    for (int sub = 0; sub < 4; ++sub) {
        const int t0 = 256 * tile + 64 * sub, tb = t0 + 16 * seg;
        { float xv[19];
#pragma unroll
          for (int k = 0; k < 19; ++k) xv[k] = bf2f(xr[k]);
#pragma unroll
          for (int k = 0; k < 16; ++k) { const float xc = cb + cw0 * xv[k] + cw1 * xv[k + 1] + cw2 * xv[k + 2] + cw3 * xv[k + 3]; sA[(16 * seg + k) * 136 + ch] = (bfu)f2bf(xc); } }
        float gt[16];
        if (PASS == 2) {
#pragma unroll
            for (int k = 0; k < 16; ++k) gt[k] = bf2f(gr[k]); }
        if (sub < 3) LR_LOADS(sub + 1);
        LDS_BARRIER();
        { const int wrow = w & 3, half = w >> 2;
          f32x4 ar[1][4], ai[1][4];
#pragma unroll
          for (int ni = 0; ni < 4; ++ni) { ar[0][ni] = (f32x4){0.f, 0.f, 0.f, 0.f}; ai[0][ni] = (f32x4){0.f, 0.f, 0.f, 0.f}; }
          wave_mma<1, 4>(ar, sA + (16 * wrow) * 136, 136, sB + (64 * half) * 136, 136, 128, fr, fq);
          wave_mma<1, 4>(ai, sA + (16 * wrow) * 136, 136, sB + (128 + 64 * half) * 136, 136, 128, fr, fq);
#pragma unroll
          for (int ni = 0; ni < 4; ++ni) { const int c2 = 64 * half + 16 * ni + fr;
#pragma unroll
              for (int j = 0; j < 4; ++j) { const int t = 16 * wrow + 4 * fq + j; const float r = sigmoidf_(ar[0][ni][j] + bav[ni]), ig = sigmoidf_(ai[0][ni][j] + bxv[ni]);
                  const float xl = r * spv[ni], a = __builtin_amdgcn_exp2f(xl), bb = __builtin_amdgcn_sqrtf(fmaxf(1.0f - a * a, 1e-12f)) * (ig * bf2f(sA[t * 136 + c2]));
                  sa[t * 129 + c2] = xl; sb[t * 129 + c2] = bb; } } }
        LDS_BARRIER();
        { float Pp = 1.f, H = 0.f;
#pragma unroll
          for (int k = 0; k < 16; ++k) { const float xl = sa[(16 * seg + k) * 129 + ch], bbv = sb[(16 * seg + k) * 129 + ch], a = __builtin_amdgcn_exp2f(xl); H = a * H + bbv; Pp *= a;
              if (PASS == 1) { XBUF[(size_t)(tb + k) * 1536 + ch0 + ch] = (bfu)f2bf(xl); BBUF[(size_t)(tb + k) * 1536 + ch0 + ch] = (bfu)f2bf(bbv); } }
          sAgg[(seg * 128 + ch) * 2] = Pp; sAgg[(seg * 128 + ch) * 2 + 1] = H; }
        LDS_BARRIER();
        if (PASS == 1) {
#pragma unroll
            for (int s = 0; s < 4; ++s) { const float p = sAgg[(s * 128 + ch) * 2], hh = sAgg[(s * 128 + ch) * 2 + 1]; carryH = p * carryH + hh; carryP *= p; }
        } else {
            float h = carryH;
            for (int s = 0; s < seg; ++s) h = sAgg[(s * 128 + ch) * 2] * h + sAgg[(s * 128 + ch) * 2 + 1];
#pragma unroll
            for (int k = 0; k < 16; ++k) { h = __builtin_amdgcn_exp2f(sa[(16 * seg + k) * 129 + ch]) * h + sb[(16 * seg + k) * 129 + ch]; A2[(size_t)(tb + k) * 1536 + ch0 + ch] = (bfu)f2bf(h * gelu_tanh(gt[k])); }
#pragma unroll
            for (int s = 0; s < 4; ++s) carryH = sAgg[(s * 128 + ch) * 2] * carryH + sAgg[(s * 128 + ch) * 2 + 1];
        }
        LDS_BARRIER();
    }
#undef LR_LOADS
    if (PASS == 1 && seg == 0) *(float2*)(AGG + ((size_t)tile * 1536 + ch0 + ch) * 2) = make_float2(carryP, carryH);
}
DI void lr_stream_unit(LAS unsigned char* lds, int unit, const bfu* __restrict__ P, const bfu* __restrict__ XBUF, const bfu* __restrict__ BBUF, const float* __restrict__ AGG, bfu* __restrict__ A2, int tid) {
    asm volatile("" : "+v"(tid));
    const int tile = unit / 12, n = unit - tile * 12, ch0 = 128 * n, ch = tid & 127, seg = tid >> 7, tb = 256 * tile + 64 * seg;
    LAS float* sAgg = (LAS float*)lds; LAS float* sAgg2 = (LAS float*)(lds + 4096);
    const unsigned base = (unsigned)tb * 1536u + (unsigned)(ch0 + ch), gbase = (unsigned)tb * 3072u + (unsigned)(ch0 + ch);
    float Pp = 1.f, H = 0.f;
    for (int hb = 0; hb < 4; ++hb) { bfu xr[16], br[16];
#pragma unroll
        for (int k = 0; k < 16; ++k) { xr[k] = XBUF[base + (unsigned)(16 * hb + k) * 1536u]; br[k] = BBUF[base + (unsigned)(16 * hb + k) * 1536u]; }
#pragma unroll
        for (int k = 0; k < 16; ++k) { const float a = __builtin_amdgcn_exp2f(bf2f(xr[k])); H = a * H + bf2f(br[k]); Pp *= a; } }
    sAgg[(seg * 128 + ch) * 2] = Pp; sAgg[(seg * 128 + ch) * 2 + 1] = H;
    { const int lo = (tile * seg) >> 2, hi = (tile * (seg + 1)) >> 2; float Pq = 1.f, Hq = 0.f;
      int k = lo;
      for (; k + 4 <= hi; k += 4) { float2 ag[4];
#pragma unroll
          for (int q = 0; q < 4; ++q) ag[q] = *(const float2*)(AGG + ((size_t)(k + q) * 1536 + ch0 + ch) * 2);
#pragma unroll
          for (int q = 0; q < 4; ++q) { Hq = ag[q].x * Hq + ag[q].y; Pq *= ag[q].x; } }
      for (; k < hi; ++k) { const float2 ag = *(const float2*)(AGG + ((size_t)k * 1536 + ch0 + ch) * 2); Hq = ag.x * Hq + ag.y; Pq *= ag.x; }
      sAgg2[(seg * 128 + ch) * 2] = Pq; sAgg2[(seg * 128 + ch) * 2 + 1] = Hq; }
    LDS_BARRIER();
    float h = 0.f;
#pragma unroll
    for (int s = 0; s < 4; ++s) h = sAgg2[(s * 128 + ch) * 2] * h + sAgg2[(s * 128 + ch) * 2 + 1];
    for (int s = 0; s < seg; ++s) h = sAgg[(s * 128 + ch) * 2] * h + sAgg[(s * 128 + ch) * 2 + 1];
    for (int hb = 0; hb < 4; ++hb) { bfu xr[16], br[16], gr[16];
#pragma unroll
        for (int k = 0; k < 16; ++k) { xr[k] = XBUF[base + (unsigned)(16 * hb + k) * 1536u]; br[k] = BBUF[base + (unsigned)(16 * hb + k) * 1536u]; gr[k] = P[gbase + (unsigned)(16 * hb + k) * 3072u]; }
#pragma unroll
        for (int k = 0; k < 16; ++k) { h = __builtin_amdgcn_exp2f(bf2f(xr[k])) * h + bf2f(br[k]); A2[base + (unsigned)(16 * hb + k) * 1536u] = (bfu)f2bf(h * gelu_tanh(bf2f(gr[k]))); } }
    LDS_BARRIER();
}
DI void da_combine(bfu* O0, const bfu* O1, const float* lamp, int gwave, int nwaves, int lane) {
    asm volatile("" : "+v"(lane));
    const float s01 = wave_sum(lamp[lane] * lamp[64 + lane]), s23 = wave_sum(lamp[128 + lane] * lamp[192 + lane]);
    const float lmb = __expf(s01) - __expf(s23) + 0.2f;
    for (int grp0 = gwave * 4 + (lane >> 4); grp0 < T * 8; grp0 += nwaves * 8) {
        size_t base[2]; u32x4 a[2], bq[2]; bool ok[2];
#pragma unroll
        for (int q = 0; q < 2; ++q) { const int grp = grp0 + q * nwaves * 4; ok[q] = grp < T * 8; const int gg = ok[q] ? grp : grp0; base[q] = (size_t)(gg >> 3) * 1024 + (gg & 7) * 128 + (lane & 15) * 8; a[q] = *(const u32x4*)(O0 + base[q]); bq[q] = *(const u32x4*)(O1 + base[q]); }
#pragma unroll
        for (int q = 0; q < 2; ++q) { float o[8], ss = 0.f;
#pragma unroll
            for (int j = 0; j < 4; ++j) { o[2 * j] = bf2f(a[q][j] & 0xffffu) - lmb * bf2f(bq[q][j] & 0xffffu); o[2 * j + 1] = bf2f(a[q][j] >> 16) - lmb * bf2f(bq[q][j] >> 16); ss += o[2 * j] * o[2 * j] + o[2 * j + 1] * o[2 * j + 1]; }
            ss += __shfl_xor(ss, 1); ss += __shfl_xor(ss, 2); ss += __shfl_xor(ss, 4); ss += __shfl_xor(ss, 8);
            const float rstd = __builtin_amdgcn_rsqf(ss * (1.0f / 128.0f) + EPS); u32x4 r;
#pragma unroll
            for (int j = 0; j < 4; ++j) r[j] = pk2(o[2 * j] * rstd, o[2 * j + 1] * rstd);
            if (ok[q]) *(u32x4*)(O0 + base[q]) = r; } }
}
struct Args { const float* in[31]; float* out; unsigned char* ws; };
#define GAS __attribute__((address_space(1)))
DI unsigned char* opq(unsigned char* p) { GAS unsigned char* g = (GAS unsigned char*)p; asm volatile("" : "+s"(g)); return (unsigned char*)g; }
#define TID_O() ({ int t_ = threadIdx.x; asm volatile("" : "+v"(t_)); t_; })
DI const float* inp(const Args& a, int i) { asm volatile("" : "+s"(i)); const GAS float* g = (const GAS float*)a.in[i]; asm volatile("" : "+s"(g)); return (const float*)g; }
#define STAT ((float*)(opq(ws) + WS_STAT))
#define SGSTAT ((float*)(opq(ws) + WS_SGSTAT))
#define RTSS ((float*)(opq(ws) + WS_RTSS))
#define LRAGG ((float*)(opq(ws) + WS_LRAGG))
#define XB ((bfu*)(opq(ws) + WS_XB))
#define W1IN ((bfu*)(opq(ws) + WS_W1IN))
#define W1OUT ((bfu*)(opq(ws) + WS_W1OUT))
#define W2IN ((bfu*)(opq(ws) + WS_W2IN))
#define W2OUT ((bfu*)(opq(ws) + WS_W2OUT))
#define WMIN ((bfu*)(opq(ws) + WS_WMIN))
#define WMOUT ((bfu*)(opq(ws) + WS_WMOUT))
#define WAX ((bfu*)(opq(ws) + WS_WAX))
#define ACT ((bfu*)(opq(ws) + WS_ACT))
#define SR ((bfu*)(opq(ws) + WS_SR))
DI void convert_weights(const Args& args, unsigned char* ws, int groups, int l, int widx, int nw, LAS float* scr, int lane_o) {
    constexpr int I_FIN = (D / 64) * (2 * FF / 32), I_FOUT = (FF / 64) * (D / 32);
    const float* wmi; const float* wmo; int NMI, KMO, MAPI = 0, gmask = 0x7fffffff; const float* gmo = nullptr; float gsc = 1.0f;
    if (l == 0) { wmi = inp(args, 8); wmo = inp(args, 13); NMI = 3072; KMO = 1024; MAPI = 2; gmo = inp(args, 12); gmask = 127; gsc = 0.8f; }
    else if (l == 1) { wmi = inp(args, 14); wmo = inp(args, 16); NMI = 6144; KMO = 2048; gmo = inp(args, 15); }
    else if (l == 2) { wmi = inp(args, 17); wmo = inp(args, 21); NMI = 6144; KMO = 3072; }
    else { wmi = inp(args, 22); wmo = inp(args, 30); NMI = 3072; KMO = 1536; }
    const int nAi = (groups & 1) ? I_FIN : 0, nAo = (groups & 1) ? I_FOUT : 0, nCi = (groups & 4) ? I_FIN : 0, nCo = (groups & 4) ? I_FOUT : 0;
    const int I_MI = (groups & 2) ? (D / 64) * (NMI / 32) : 0, I_MO = (groups & 2) ? (KMO / 64) * (D / 32) : 0, I_AX = ((groups & 2) && l == 3) ? 192 : 0;
    const int NIT = nAi + nAo + nCi + nCo + I_MI + I_MO + I_AX;
    for (int it = widx; it < NIT; it += nw) { CvItem cur; f32x4 cv[8]; float cg[8]; int r = it;
        do {
            if (r < nAi) { cv_make(cur, r, inp(args, 2) + (size_t)l * D * 2 * FF, D, 2 * FF, W1IN, 1, inp(args, 1) + l * D, 0x7fffffff, 1.0f); break; } r -= nAi;
            if (r < nCi) { cv_make(cur, r, inp(args, 6) + (size_t)l * D * 2 * FF, D, 2 * FF, W2IN, 1, inp(args, 5) + l * D, 0x7fffffff, 1.0f); break; } r -= nCi;
            if (r < nAo) { cv_make(cur, r, inp(args, 3) + (size_t)l * FF * D, FF, D, W1OUT, 0, nullptr, 0, 1.0f); break; } r -= nAo;
            if (r < nCo) { cv_make(cur, r, inp(args, 7) + (size_t)l * FF * D, FF, D, W2OUT, 0, nullptr, 0, 1.0f); break; } r -= nCo;
            if (r < I_MI) { cv_make(cur, r, wmi, D, NMI, WMIN, MAPI, inp(args, 4) + l * D, 0x7fffffff, 1.0f); break; } r -= I_MI;
            if (r < I_MO) { cv_make(cur, r, wmo, KMO, D, WMOUT, 0, gmo, gmask, gsc); break; } r -= I_MO;
            { const int nwx = r >> 3, itx = r & 7, n = nwx >> 1, which = nwx & 1;
              cv_make(cur, itx, (which ? inp(args, 27) : inp(args, 25)) + (size_t)n * 16384, 128, 128, WAX + (size_t)n * 32768 + which * 16384, 0, nullptr, 0, 1.0f); }
        } while (0);
        cv_load(cur, cv, cg, lane_o); cv_store(cur, cv, cg, scr, lane_o); }
}
#define XB_TMO      128
#define XB_XCNT(j)  (256  + 64 * (j))
#define XB_XSUB(j)  (1280 + 64 * (j))
#define XB_XGEN(j)  (2304 + 64 * (j))
#define XB_TOP      3328
#define XB_TOPGEN   3392
#define XCD_BAR_WORDS 3456
#define XB_SPIN_CAP (1u << 18)

__device__ __forceinline__ unsigned xb_ld(unsigned* p)              { return __hip_atomic_load(p, __ATOMIC_RELAXED, __HIP_MEMORY_SCOPE_AGENT); }
__device__ __forceinline__ unsigned xb_add(unsigned* p, unsigned v) { return __hip_atomic_fetch_add(p, v, __ATOMIC_RELAXED, __HIP_MEMORY_SCOPE_AGENT); }
__device__ __forceinline__ unsigned xb_xcc_id() { return (unsigned)__builtin_amdgcn_s_getreg((3 << 11) | 20) & 0xFu; }
#define XB_SPIN(cond, bar) do { unsigned _sp = 0; while (cond) { __builtin_amdgcn_s_sleep(1); \
    if ((++_sp & 255u) == 0u) { if (xb_ld(&(bar)[XB_TMO])) break; if (_sp > XB_SPIN_CAP) { atomicAdd(&(bar)[XB_TMO], 1u); break; } } } } while (0)

struct XcdBarrier {
    unsigned* bar; unsigned x;
    volatile LAS unsigned* st;
};

__device__ __forceinline__ XcdBarrier xcd_barrier_post(unsigned* bar, volatile LAS unsigned* st) {
    XcdBarrier b; b.bar = bar; b.x = xb_xcc_id(); b.st = st;
    if (threadIdx.x == 0) (void)xb_add(&bar[XB_XCNT(b.x)], 1u);
    return b;
}
__device__ __forceinline__ void xcd_barrier_complete(unsigned* bar, unsigned x, unsigned& nloc, unsigned& nx) {
    const unsigned G = gridDim.x * gridDim.y * gridDim.z;
    unsigned sum, cnt, mine, sp = 0u;
    for (;;) {
        sum = 0u; cnt = 0u; mine = 0u;
#pragma unroll
        for (unsigned j = 0; j < 16; ++j) { const unsigned c = xb_ld(&bar[XB_XCNT(j)]); sum += c; cnt += (c > 0u) ? 1u : 0u; mine = (j == x) ? c : mine; }
        if (sum == G) break;
        __builtin_amdgcn_s_sleep(1);
        if ((++sp & 255u) == 0u) { if (xb_ld(&bar[XB_TMO])) break; if (sp > XB_SPIN_CAP) { atomicAdd(&bar[XB_TMO], 1u); break; } }
    }
    nloc = mine > 0u ? mine : 1u; nx = cnt > 0u ? cnt : 1u;
}

__device__ __forceinline__ void xcd_barrier(const XcdBarrier& b) {
    asm volatile("s_waitcnt vmcnt(0)" ::: "memory");
    __syncthreads();
    if (threadIdx.x == 0) {
        unsigned* bar = b.bar;
        __builtin_amdgcn_s_waitcnt(0);
        unsigned nloc = b.st[0], nx = b.st[1];
        if (nloc == 0u) { xcd_barrier_complete(bar, b.x, nloc, nx); b.st[0] = nloc; b.st[1] = nx; }
        const unsigned old = xb_add(&bar[XB_XSUB(b.x)], 1u);
        const unsigned gen = old / nloc;
        if (old + 1u == (gen + 1u) * nloc) {
            __builtin_amdgcn_fence(__ATOMIC_RELEASE, "agent");
            asm volatile("s_waitcnt vmcnt(0)" ::: "memory");
            const unsigned og = xb_add(&bar[XB_TOP], 1u);
            const unsigned tg = og / nx;
            if (og + 1u == (tg + 1u) * nx) xb_add(&bar[XB_TOPGEN], 1u);
            else XB_SPIN(xb_ld(&bar[XB_TOPGEN]) == tg, bar);
            __builtin_amdgcn_fence(__ATOMIC_ACQUIRE, "agent");
            xb_add(&bar[XB_XGEN(b.x)], 1u);
            asm volatile("s_waitcnt vmcnt(0)" ::: "memory");
        } else {
            XB_SPIN(xb_ld(&bar[XB_XGEN(b.x)]) == gen, bar);
            __builtin_amdgcn_fence(__ATOMIC_ACQUIRE, "agent");
            asm volatile("s_waitcnt vmcnt(0)" ::: "memory");
        }
    }
    __syncthreads();
}

#ifndef REP_ATT
#define REP_ATT 1
#endif
#ifndef REP_FFO
#define REP_FFO 1
#endif
#ifndef REP_RTC
#define REP_RTC 1
#endif
#ifndef REP_SG
#define REP_SG 1
#endif
#ifndef GEMM_ALIGN
#define GEMM_ALIGN true
#endif
#ifndef GEMM_SP2
#define GEMM_SP2 true
#endif
#ifndef REP_CV
#define REP_CV 1
#endif
#ifndef REP_LR
#define REP_LR 1
#endif
#ifndef REP_RTS
#define REP_RTS 1
#endif
#ifndef REP_FFI
#define REP_FFI 1
#endif
__global__ void __launch_bounds__(512, 2) mk_fwd(Args args) {
    extern __shared__ __attribute__((aligned(16))) unsigned char lds_raw[];
    cg::grid_group grid = cg::this_grid();
    LAS unsigned char* lds = (LAS unsigned char*)lds_raw;
    const int G = gridDim.x, bx = blockIdx.x;
    volatile LAS unsigned* bst = (volatile LAS unsigned*)(lds + 163824);
    if (threadIdx.x < 2) bst[threadIdx.x] = 0u;
    if (bx == 0) for (int i = threadIdx.x; i < XCD_BAR_WORDS; i += 512) ((unsigned*)(args.ws + WS_CTL + 4096))[i] = 0u;
    __syncthreads();
    XcdBarrier xbar; xbar.bar = (unsigned*)(args.ws + WS_CTL + 4096); xbar.x = 0; xbar.st = bst;
#define GSYNC() xcd_barrier(xbar)
#define tid TID_O()
#define lane (TID_O() & 63)
#define wave __builtin_amdgcn_readfirstlane(TID_O() >> 6)
#define gwave (bx * 8 + wave)
#define nwaves (G * 8)
#define gtid (bx * 512 + TID_O())
#define gthreads (G * 512)
    unsigned char* ws = args.ws;
    float* OUT = args.out;

#pragma unroll 1
    for (int st = 0; st < 12; ++st) {
        const int l = st / 3, ph = st - 3 * l;
        if (st == 0) {
            const int lane_o = lane; const int gw_o = gwave;
            convert_weights(args, ws, 3, 0, gw_o, nwaves, (LAS float*)(lds + wave * 16384), lane_o);
            if (bx == 0 && TID_O() < 2) ((unsigned*)(opq(ws) + WS_CTL))[64 * TID_O()] = 0u;
                for (int m = gw_o; m < T; m += 2 * nwaves) {
                    const int m2 = m + nwaves; const bool two = m2 < T;
                    const f32x4* xr = (const f32x4*)(inp(args, 0) + (size_t)m * D) + lane_o; const f32x4* xr2 = (const f32x4*)(inp(args, 0) + (size_t)(two ? m2 : m) * D) + lane_o;
                    f32x4 v[4], v2[4];
#pragma unroll
                    for (int j = 0; j < 4; ++j) { v[j] = xr[64 * j]; v2[j] = xr2[64 * j]; }
                    float s = 0.f, s2 = 0.f;
                    unsigned long long* o8 = (unsigned long long*)(XB + (size_t)m * D) + lane_o; unsigned long long* o82 = (unsigned long long*)(XB + (size_t)(two ? m2 : m) * D) + lane_o;
#pragma unroll
                    for (int j = 0; j < 4; ++j) { s += (v[j][0] * v[j][0] + v[j][1] * v[j][1]) + (v[j][2] * v[j][2] + v[j][3] * v[j][3]); s2 += (v2[j][0] * v2[j][0] + v2[j][1] * v2[j][1]) + (v2[j][2] * v2[j][2] + v2[j][3] * v2[j][3]);
                        o8[64 * j] = (unsigned long long)pk2(v[j][0], v[j][1]) | ((unsigned long long)pk2(v[j][2], v[j][3]) << 32);
                        if (two) o82[64 * j] = (unsigned long long)pk2(v2[j][0], v2[j][1]) | ((unsigned long long)pk2(v2[j][2], v2[j][3]) << 32); }
                    s = wave_sum(s); s2 = wave_sum(s2);
                    if (lane_o < 16) { STAT[(size_t)m * 16 + lane_o] = (lane_o == 0) ? s : 0.f; if (two) STAT[(size_t)m2 * 16 + lane_o] = (lane_o == 0) ? s2 : 0.f; } }
            grid.sync(); xbar = xcd_barrier_post((unsigned*)(args.ws + WS_CTL + 4096), bst);
        }
        if (ph != 1) {
            bfu* H = ACT;
            for (int rep = 0; rep < REP_FFI; ++rep)
            { pg8::Gemm g{XB, ph == 0 ? W1IN : W2IN, T, 2 * FF, D}; pg8::StaticOrder S; S.init(T, 2 * FF, G, bx);
              pg8::rstd_table(lds, STAT, S, TID_O());
              pg8::EpiSwiGLU E{H, (const LAS float*)(lds + pg8::RSTD_OFF)};
              pg8::gemm_phase<pg8::EpiSwiGLU, pg8::StaticOrder, GEMM_ALIGN, GEMM_SP2>(lds, g, S, E);
              if (ph == 0 || l < 3) { const int nwg = (T / 256) * (2 * FF / 256), rounds = (nwg + G - 1) / G, nlast = nwg - (rounds - 1) * G;
                  const int grp = (ph == 0) ? 4 : 3, lay = (ph == 0) ? l : l + 1;
                  if (nlast == G) convert_weights(args, ws, grp, lay, gwave, nwaves, (LAS float*)(lds + wave * 16384), lane);
                  else if (bx >= nlast) convert_weights(args, ws, grp, lay, (bx - nlast) * 8 + wave, (G - nlast) * 8, (LAS float*)(lds + wave * 16384), lane); } }
            GSYNC();
            { pg8::Gemm g{H, ph == 0 ? W1OUT : W2OUT, T, D, FF}; pg8::StaticOrder S; S.init(T, D, G, bx);
              pg8::EpiRes E{OUT, XB, STAT, 0.5f, st == 11 ? 1 : 0};
              pg8::gemm_phase<pg8::EpiRes, pg8::StaticOrder, GEMM_ALIGN, GEMM_SP2>(lds, g, S, E); }
            GSYNC();
        } else {
            const bfu* A2 = ACT; int KMO = 1024;
#ifndef DIS_MIX
            if (l == 0) {
                bfu* Qb = ACT; bfu* Kb = ACT + (size_t)T * 1024; bfu* Vb = ACT + (size_t)2 * T * 1024; bfu* O0 = ACT + (size_t)3 * T * 1024; bfu* O1 = ACT + (size_t)4 * T * 1024;
                { pg8::Gemm g{XB, WMIN, T, 3072, D}; pg8::StaticOrder S; S.init(T, 3072, G, bx);
                  pg8::rstd_table(lds, STAT, S, TID_O());
                  pg8::EpiRoute<0> E{Qb, Kb, Vb, nullptr, (const LAS float*)(lds + pg8::RSTD_OFF), nullptr, inp(args, 9), inp(args, 10)};
                  pg8::gemm_phase<pg8::EpiRoute<0>, pg8::StaticOrder, GEMM_ALIGN, GEMM_SP2>(lds, g, S, E); }
                GSYNC();
#ifndef DIS_ATTN
                {
                    int ln = lane; asm volatile("" : "+v"(ln));
                    float gq = fabsf(inp(args, 9)[ln]), gk = fabsf(inp(args, 10)[ln]);
#pragma unroll
                    for (int o = 1; o < 64; o <<= 1) { const int src = (ln ^ o) << 2;
                        gq = fmaxf(gq, __int_as_float(__builtin_amdgcn_ds_bpermute(src, __float_as_int(gq)))); gk = fmaxf(gk, __int_as_float(__builtin_amdgcn_ds_bpermute(src, __float_as_int(gk)))); }
                    const float bound = __int_as_float(__builtin_amdgcn_readfirstlane(__float_as_int(16.0f * gq * gk + 30.0f)));
                    volatile LAS unsigned* sU = (volatile LAS unsigned*)(lds + 140 * 1024);
                    for (int rep = 0; rep < REP_ATT; ++rep) {
                    unsigned* qctr = (unsigned*)(opq(ws) + WS_CTL) + 64 * rep;
                    for (;;) {
                        if (TID_O() == 0) sU[0] = atomicAdd(qctr, 1u);
                        __syncthreads();
                        const int u = (int)sU[0];
                        __syncthreads();
                        if (u >= 1024) break;
                        const int hh = 7 - (u >> 7), r = u & 127, qb = 63 - (r >> 1), mm = r & 1, hm = hh * 2 + mm;
                        const float slope = exp2f(-(float)(hh + 1)); const float sl2 = slope * LOG2E;
                        const int ks = qb * 256 - (int)ceilf(bound / slope); const int t0 = ks <= 0 ? 0 : ((ks >> 6) & ~1);
                        attn_body::attn_unit<8>(qb, t0, sl2, (const attn_body::bf16*)(Qb + hm * 64), (const attn_body::bf16*)(Kb + hm * 64), (const attn_body::bf16*)(Vb + hh * 128),
                                                (attn_body::bf16*)((mm ? O1 : O0) + hh * 128), (char*)lds_raw);
                    }
                    }
                }
#endif
                GSYNC();
                da_combine(O0, O1, inp(args, 11), gwave, nwaves, lane);
                A2 = O0; KMO = 1024;
            } else if (l == 1) {
                bfu* Qb = ACT; bfu* Kb = ACT + (size_t)T * 1024; bfu* Vb = ACT + (size_t)2 * T * 1024; bfu* Gb = ACT + (size_t)4 * T * 1024;
                { pg8::Gemm g{XB, WMIN, T, 6144, D}; pg8::StaticOrder S; S.init(T, 6144, G, bx);
                  pg8::rstd_table(lds, STAT, S, TID_O());
                  pg8::EpiRoute<1> E{Qb, Kb, Vb, Gb, (const LAS float*)(lds + pg8::RSTD_OFF), nullptr, nullptr, nullptr};
                  pg8::gemm_phase<pg8::EpiRoute<1>, pg8::StaticOrder, GEMM_ALIGN, GEMM_SP2>(lds, g, S, E); }
                GSYNC();
#ifndef DIS_RT
                rt_state_phase(lds, bx, G, Kb, Vb, SR, tid);
                GSYNC();
                rt_scan(SR, gtid, gthreads);
                GSYNC();
                for (int u = bx; u < 512; u += G) rt_chunk_unit(lds, u, Qb, Kb, Vb, Vb, Gb, SR, tid);
#endif
                A2 = Vb; KMO = 2048;
            } else if (l == 2) {
                bfu* Ub = ACT; bfu* Vb = ACT + (size_t)T * 3072;
                { pg8::Gemm g{XB, WMIN, T, 6144, D}; pg8::StaticOrder S; S.init(T, 6144, G, bx);
                  pg8::rstd_table(lds, STAT, S, TID_O());
                  pg8::EpiRoute<2> E{Ub, Vb, nullptr, nullptr, (const LAS float*)(lds + pg8::RSTD_OFF), SGSTAT, nullptr, nullptr};
                  pg8::gemm_phase<pg8::EpiRoute<2>, pg8::StaticOrder, GEMM_ALIGN, GEMM_SP2>(lds, g, S, E); }
                GSYNC();
#ifndef DIS_SG
#if REP_SG > 1
                for (int u = bx; u < 1024; u += G) sg_unit(lds, u, Ub, SR, Vb, SGSTAT, inp(args, 19), inp(args, 20), inp(args, 18), tid);
#endif
                for (int u = bx; u < 1024; u += G) sg_unit(lds, u, Ub, Ub, Vb, SGSTAT, inp(args, 19), inp(args, 20), inp(args, 18), tid);
#endif
                A2 = Ub; KMO = 3072;
            } else {
                bfu* P = ACT; bfu* A2w = ACT + (size_t)T * 3072;
                { pg8::Gemm g{XB, WMIN, T, 3072, D}; pg8::StaticOrder S; S.init(T, 3072, G, bx);
                  pg8::rstd_table(lds, STAT, S, TID_O());
                  pg8::EpiRoute<3> E{P, nullptr, nullptr, nullptr, (const LAS float*)(lds + pg8::RSTD_OFF), nullptr, nullptr, nullptr};
                  pg8::gemm_phase<pg8::EpiRoute<3>, pg8::StaticOrder, GEMM_ALIGN, GEMM_SP2>(lds, g, S, E); }
                GSYNC();
#ifndef DIS_LR
                for (int u = bx; u < 768; u += G) lr_unit<1>(lds, u, P, WAX, inp(args, 23), inp(args, 24), inp(args, 26), inp(args, 28), inp(args, 29), LRAGG, A2w, SR, SR + (size_t)T * 1536, tid);
                GSYNC();
                for (int u = bx; u < 768; u += G) lr_stream_unit(lds, u, P, SR, SR + (size_t)T * 1536, LRAGG, A2w, tid);
#endif
                A2 = A2w; KMO = 1536;
            }
#endif
            GSYNC();
            { pg8::Gemm g{A2, WMOUT, T, D, KMO}; pg8::StaticOrder S; S.init(T, D, G, bx);
              pg8::EpiRes E{OUT, XB, STAT, 1.0f, 0};
              pg8::gemm_phase<pg8::EpiRes, pg8::StaticOrder, GEMM_ALIGN, GEMM_SP2>(lds, g, S, E); }
            GSYNC();
        }
    }
}

#undef tid
#undef lane
#undef wave
#undef gwave
#undef nwaves
#undef gtid
#undef gthreads
extern "C" void kernel_launch(void* const* d_in, const int* in_sizes, int n_in, void* d_out, int out_size, void* d_ws, size_t ws_size, hipStream_t stream) {
    static int grid = 0;
    if (grid == 0) {
        if (n_in != 31 || out_size != T * D || ws_size < WS_END) { fprintf(stderr, "kernel_launch: unexpected shapes (n_in %d out %d ws %zu need %zu)\n", n_in, out_size, ws_size, (size_t)WS_END); grid = -1; return; }
        int dev = 0, cus = 0, per_cu = 0;
        (void)hipGetDevice(&dev);
        (void)hipDeviceGetAttribute(&cus, hipDeviceAttributeMultiprocessorCount, dev);
        (void)hipFuncSetAttribute((const void*)mk_fwd, hipFuncAttributeMaxDynamicSharedMemorySize, LDS_BYTES);
        (void)hipOccupancyMaxActiveBlocksPerMultiprocessor(&per_cu, (const void*)mk_fwd, 512, LDS_BYTES);
        (void)hipGetLastError();
        grid = cus;
        fprintf(stderr, "kernel_launch: grid %d (occupancy query %d per CU), ws %zu\n", grid, per_cu, ws_size);
    }
    if (grid < 0) return;
    Args a{};
    for (int i = 0; i < 31; ++i) a.in[i] = (const float*)d_in[i];
    a.out = (float*)d_out; a.ws = (unsigned char*)d_ws;
    void* kargs[] = {&a};
    hipError_t e = hipLaunchCooperativeKernel((void*)mk_fwd, dim3(grid), dim3(512), kargs, LDS_BYTES, stream);
    if (e != hipSuccess) fprintf(stderr, "kernel_launch: cooperative launch failed: %s (grid %d)\n", hipGetErrorString(e), grid);
}
```

```cpp
#include <hip/hip_runtime.h>
#include <hip/hip_cooperative_groups.h>
#include <cstdio>
#include <cstdint>
namespace cg = cooperative_groups;
namespace pg8 {
#define PG8_LAS __attribute__((address_space(3)))
typedef unsigned short bf16_t;
typedef short bf16x8 __attribute__((ext_vector_type(8)));
typedef float f32x4 __attribute__((ext_vector_type(4)));
typedef unsigned u32x4 __attribute__((ext_vector_type(4)));
constexpr int BM = 256, BK = 64, HALF = 128, HTB = HALF * BK * 2  , STAGE_BYTES = 8 * HTB, NXCD = 8, WGM = 8;

__host__ __device__ __forceinline__ int lds_byte(int r, int c) { const int st = (r >> 4) * 2 + (c >> 5), rr = r & 15, cc = c & 31, ob = rr * 64 + cc * 2; return st * 1024 + (ob ^ (((ob >> 9) & 1) << 5)); }
__host__ __device__ __forceinline__ void stage_rc(int b, int& R, int& C) { const int st = b / 1024, sb = b % 1024, swz = sb ^ (((sb >> 9) & 1) << 5); R = (st >> 1) * 16 + swz / 64; C = (st & 1) * 32 + (swz % 64) / 2; }
__host__ __device__ __forceinline__ int perm32(int rho) { const int n = rho >> 4, i = rho & 15; return 8 * (i >> 2) + 4 * n + (i & 3); }

struct Unit { int pm, pn, slot; };
struct Gemm { const bf16_t* A; const bf16_t* Bt; int M, N, K; };

struct StaticOrder {
    int nM, nN, nwg, G, c;
    __host__ __device__ void init(int M, int N, int G_, int c_) { nM = M / BM; nN = N / BM; nwg = nM * nN; G = G_; c = c_; }
    __host__ __device__ bool next(int i, Unit& u) const {
        const long L = (long)i * G + c; if (L >= nwg) return false;
        int wgid = (int)L; { const int q = nwg / NXCD, r = nwg % NXCD, xcd = wgid % NXCD, off = wgid / NXCD; wgid = (xcd < r ? xcd * (q + 1) : r * (q + 1) + (xcd - r) * q) + off; }
        const int nig = WGM * nN, gid = wgid / nig, fm = gid * WGM, gsz = (nM - fm) < WGM ? (nM - fm) : WGM;
        u.pm = fm + ((wgid % nig) % gsz); u.pn = (wgid % nig) / gsz; u.slot = i; return true;
    }
    __device__ __forceinline__ void a_ready(const Unit&) const {}
    __device__ __forceinline__ void done(const Unit&) const {}
};
__device__ __forceinline__ unsigned cvt_pk_bf16(float lo, float hi) { unsigned r; asm volatile("v_cvt_pk_bf16_f32 %0, %1, %2" : "=v"(r) : "v"(lo), "v"(hi)); return r; }
typedef float f32x2 __attribute__((ext_vector_type(2)));
__device__ __forceinline__ f32x2 gelu_pk(f32x2 v) {
    const f32x2 av = __builtin_elementwise_abs(v), d = av * 0.2316418882f + 1.0f;
    f32x2 t; t.x = __builtin_amdgcn_rcpf(d.x); t.y = __builtin_amdgcn_rcpf(d.y);
    f32x2 q = t * 0.5307027145f + (-0.7265760135f); q = q * t + 0.7107068705f; q = q * t + (-0.142248368f); q = q * t + 0.127414796f; q = q * t;
    const f32x2 s = (v * v) * (-0.72134752044f);
    f32x2 e; e.x = __builtin_amdgcn_exp2f(s.x); e.y = __builtin_amdgcn_exp2f(s.y);
    const f32x2 m = v * (q * e), r = v - m;
    f32x2 o; o.x = v.x < 0.f ? m.x : r.x; o.y = v.y < 0.f ? m.y : r.y; return o;
}
constexpr float RMS_EPS = 1e-6f;
constexpr float LOG2E = 1.4426950408889634f;
typedef unsigned u32x2 __attribute__((ext_vector_type(2)));
__device__ __forceinline__ float fast_sigmoid(float y) { return __builtin_amdgcn_rcpf(1.0f + __builtin_amdgcn_exp2f(-y * LOG2E)); }
__device__ __forceinline__ float silu_f(float x) { return x * fast_sigmoid(x); }
__device__ __forceinline__ float gelu_tanh_f(float x) { return x * fast_sigmoid(1.5957691216057308f * (x + 0.044715f * x * x * x)); }
__device__ __forceinline__ float row_sumsq16(const float* p16) { const f32x4* p = (const f32x4*)p16; const f32x4 a = p[0], b = p[1], c = p[2], d = p[3];
    return (((a[0] + a[1]) + (a[2] + a[3])) + ((b[0] + b[1]) + (b[2] + b[3]))) + (((c[0] + c[1]) + (c[2] + c[3])) + ((d[0] + d[1]) + (d[2] + d[3]))); }
constexpr int RSTD_OFF = 131072;
template <class Sched> __device__ __forceinline__ void rstd_table(PG8_LAS unsigned char* lds, const float* stat, const Sched& S, int tid) {
    if (tid < 256) {
        f32x4 v[8][4]; int nu = 0; Unit u;
#pragma unroll
        for (int i = 0; i < 8; ++i) { if (S.next(i, u)) { const f32x4* p = (const f32x4*)(stat + (size_t)(u.pm * BM + tid) * 16); v[i][0] = p[0]; v[i][1] = p[1]; v[i][2] = p[2]; v[i][3] = p[3]; nu = i + 1; }
            else { v[i][0] = v[i][1] = v[i][2] = v[i][3] = (f32x4){0.f, 0.f, 0.f, 0.f}; } }
#pragma unroll
        for (int i = 0; i < 8; ++i) if (i < nu) { const f32x4 a = v[i][0], b = v[i][1], c = v[i][2], d = v[i][3];
            const float s = (((a[0] + a[1]) + (a[2] + a[3])) + ((b[0] + b[1]) + (b[2] + b[3]))) + (((c[0] + c[1]) + (c[2] + c[3])) + ((d[0] + d[1]) + (d[2] + d[3])));
            ((PG8_LAS float*)(lds + RSTD_OFF))[i * 256 + tid] = __builtin_amdgcn_rsqf(s * (1.0f / 1024.0f) + RMS_EPS); }
        for (int i = 8; S.next(i, u); ++i) ((PG8_LAS float*)(lds + RSTD_OFF))[i * 256 + tid] = __builtin_amdgcn_rsqf(row_sumsq16(stat + (size_t)(u.pm * BM + tid) * 16) * (1.0f / 1024.0f) + RMS_EPS);
    }
    __syncthreads();
}
__device__ __forceinline__ void load_rstd(const PG8_LAS float* tab, const Unit& u, int wr, int fr, float (&rs)[2][4]) {
#pragma unroll
    for (int ai = 0; ai < 2; ++ai)
#pragma unroll
        for (int m = 0; m < 4; ++m) rs[ai][m] = tab[u.slot * 256 + ai * HALF + wr * 64 + m * 16 + fr];
}
struct EpiSwiGLU {
    static constexpr bool PERM = true, AFTER_DRAIN = false;
    bf16_t* H; const PG8_LAS float* tab;
    __device__ __forceinline__ void operator()(const f32x4 (&acc)[2][2][4][2], const Unit& u, int wr, int wc, int fr, int fq) const {
        const int row0 = u.pm * BM + wr * 64 + fr, col0 = u.pn * HALF + wc * 32 + 8 * fq;
        float rs[2][4]; load_rstd(tab, u, wr, fr, rs);
#pragma unroll
        for (int ai = 0; ai < 2; ++ai)
#pragma unroll
            for (int m = 0; m < 4; ++m) { const float r = rs[ai][m]; float h[8];
#pragma unroll
                for (int n = 0; n < 2; ++n)
#pragma unroll
                    for (int e = 0; e < 4; ++e) { const float a = acc[ai][0][m][n][e] * r, b = acc[ai][1][m][n][e] * r; h[4 * n + e] = silu_f(a) * b; }
                u32x4 w; w.x = cvt_pk_bf16(h[0], h[1]); w.y = cvt_pk_bf16(h[2], h[3]); w.z = cvt_pk_bf16(h[4], h[5]); w.w = cvt_pk_bf16(h[6], h[7]);
                *(u32x4*)(H + (size_t)(row0 + ai * HALF + m * 16) * 2816 + col0) = w; }
    }
};
struct EpiRes {
    static constexpr bool PERM = false, AFTER_DRAIN = false;
    float* out; bf16_t* xb; float* stat; float alpha; int fin;
    __device__ __forceinline__ void operator()(const f32x4 (&acc)[2][2][4][2], const Unit& u, int wr, int wc, int fr, int fq) const {
        const int row0 = u.pm * BM + wr * 64 + fr, col0 = u.pn * BM + wc * 32 + 4 * fq;
#pragma unroll
        for (int ai = 0; ai < 2; ++ai)
#pragma unroll
            for (int m = 0; m < 4; ++m) { const int row = row0 + ai * HALF + m * 16; const size_t off = (size_t)row * 1024 + col0; float ss = 0.f;
                u32x2 bs[2][2];
#pragma unroll
                for (int bj = 0; bj < 2; ++bj)
#pragma unroll
                    for (int n = 0; n < 2; ++n) bs[bj][n] = *(const u32x2*)(xb + off + bj * HALF + n * 16);
#pragma unroll
                for (int bj = 0; bj < 2; ++bj)
#pragma unroll
                    for (int n = 0; n < 2; ++n) { f32x4 o; o[0] = __uint_as_float(bs[bj][n].x << 16); o[1] = __uint_as_float(bs[bj][n].x & 0xffff0000u); o[2] = __uint_as_float(bs[bj][n].y << 16); o[3] = __uint_as_float(bs[bj][n].y & 0xffff0000u);
                        o = o + acc[ai][bj][m][n] * alpha; ss += (o[0] * o[0] + o[1] * o[1]) + (o[2] * o[2] + o[3] * o[3]);
                        if (fin) *(f32x4*)(out + off + bj * HALF + n * 16) = o;
                        else { u32x2 w; w.x = cvt_pk_bf16(o[0], o[1]); w.y = cvt_pk_bf16(o[2], o[3]); *(u32x2*)(xb + off + bj * HALF + n * 16) = w; } }
                ss += __shfl_xor(ss, 16); ss += __shfl_xor(ss, 32);
                if (fq == 0) stat[(size_t)row * 16 + u.pn * 4 + wc] = ss; }
    }
};
template <int MODE> struct EpiRoute {
    static constexpr bool PERM = true, AFTER_DRAIN = false;
    bf16_t *d0, *d1, *d2, *d3; const PG8_LAS float* tab; float* stat2; const float *g0, *g1;
    __device__ __forceinline__ void operator()(const f32x4 (&acc)[2][2][4][2], const Unit& u, int wr, int wc, int fr, int fq) const {
        const int row0 = u.pm * BM + wr * 64 + fr; const int pn = u.pn;
        float rs[2][4]; load_rstd(tab, u, wr, fr, rs);
        if (MODE == 0 && pn < 8) {
            const bool isq = pn < 4; bf16_t* dst = isq ? d0 : d1; const float* gp = isq ? g0 : g1; const float sc = isq ? 0.125f * LOG2E : 1.0f;
            f32x4 gv[2][2];
#pragma unroll
            for (int bj = 0; bj < 2; ++bj)
#pragma unroll
                for (int n = 0; n < 2; ++n) gv[bj][n] = *(const f32x4*)(gp + 32 * bj + 8 * fq + 4 * n);
            const int colb = 256 * (pn & 3) + 64 * wc + 8 * fq;
#pragma unroll
            for (int ai = 0; ai < 2; ++ai)
#pragma unroll
                for (int m = 0; m < 4; ++m) { const float r = rs[ai][m]; f32x4 v[2][2]; float ss = 0.f;
#pragma unroll
                    for (int bj = 0; bj < 2; ++bj)
#pragma unroll
                        for (int n = 0; n < 2; ++n) { v[bj][n] = acc[ai][bj][m][n] * r; ss += (v[bj][n][0] * v[bj][n][0] + v[bj][n][1] * v[bj][n][1]) + (v[bj][n][2] * v[bj][n][2] + v[bj][n][3] * v[bj][n][3]); }
                    ss += __shfl_xor(ss, 16); ss += __shfl_xor(ss, 32);
                    const float nr = __builtin_amdgcn_rsqf(ss * (1.0f / 64.0f) + RMS_EPS) * sc;
                    bf16_t* rowp = dst + (size_t)(row0 + ai * HALF + m * 16) * 1024 + colb;
#pragma unroll
                    for (int bj = 0; bj < 2; ++bj) { const f32x4 a = v[bj][0] * gv[bj][0] * nr, b = v[bj][1] * gv[bj][1] * nr;
                        u32x4 w; w.x = cvt_pk_bf16(a[0], a[1]); w.y = cvt_pk_bf16(a[2], a[3]); w.z = cvt_pk_bf16(b[0], b[1]); w.w = cvt_pk_bf16(b[2], b[3]);
                        *(u32x4*)(rowp + 32 * bj) = w; } }
            return;
        }
        bf16_t* dst; int pitch, tile; int act = 0; float sc = 1.0f; bool sq = false;
        if (MODE == 0) { dst = d2; pitch = 1024; tile = pn - 8; }
        else if (MODE == 1) { if (pn < 4) { dst = d0; pitch = 1024; tile = pn; } else if (pn < 8) { dst = d1; pitch = 1024; tile = pn - 4; sc = 0.0625f; } else if (pn < 16) { dst = d2; pitch = 2048; tile = pn - 8; } else { dst = d3; pitch = 2048; tile = pn - 16; act = 1; } }
        else if (MODE == 2) { act = 2; pitch = 3072; if (pn < 12) { dst = d0; tile = pn; } else { dst = d1; tile = pn - 12; sq = true; } }
        else { dst = d0; pitch = 3072; tile = pn; }
        const int colb = 256 * tile + 32 * wc + 8 * fq;
#pragma unroll
        for (int ai = 0; ai < 2; ++ai)
#pragma unroll
            for (int m = 0; m < 4; ++m) { const int row = row0 + ai * HALF + m * 16; const float r = rs[ai][m] * sc; float ss = 0.f;
                bf16_t* rowp = dst + (size_t)row * pitch + colb;
#pragma unroll
                for (int bj = 0; bj < 2; ++bj) { float h[8];
#pragma unroll
                    for (int n = 0; n < 2; ++n)
#pragma unroll
                        for (int e = 0; e < 4; ++e) { float x = acc[ai][bj][m][n][e] * r; if (MODE == 1) { if (act == 1) x = silu_f(x); } if (MODE == 2) { x = gelu_tanh_f(x); ss += x * x; } h[4 * n + e] = x; }
                    u32x4 w; w.x = cvt_pk_bf16(h[0], h[1]); w.y = cvt_pk_bf16(h[2], h[3]); w.z = cvt_pk_bf16(h[4], h[5]); w.w = cvt_pk_bf16(h[6], h[7]);
                    *(u32x4*)(rowp + bj * HALF) = w; }
                if (MODE == 2) { ss += __shfl_xor(ss, 16); ss += __shfl_xor(ss, 32); if (sq && fq == 0) stat2[(size_t)row * 48 + tile * 4 + wc] = ss; } }
    }
};
template <class Epi, class Sched, bool ALIGN_EPI = false, bool SP2 = false>
__device__ __forceinline__ void gemm_phase(PG8_LAS unsigned char* lds, const Gemm g, const Sched& S, const Epi& E) {
    int tid_o = threadIdx.x; asm volatile("" : "+v"(tid_o)); const int tid = tid_o, wid = __builtin_amdgcn_readfirstlane(tid >> 6), lane = tid & 63, wr = wid >> 2, wc = wid & 3, fr = lane & 15, fq = lane >> 4;
    const int K = g.K, nt = K / BK;
    unsigned voffA[2], voffB[2];
#pragma unroll
    for (int i = 0; i < 2; ++i) { int R, C; stage_rc(tid * 16 + i * 8192, R, C); const int Rb = Epi::PERM ? ((R & ~31) + perm32(R & 31)) : R;
        voffA[i] = (unsigned)(R * K + C) * 2u; voffB[i] = (unsigned)(Rb * K + C) * 2u; }
    const size_t kstep = (size_t)(BK * 2);
    const size_t hstep = (size_t)HALF * K * 2;
    const size_t tstep = 2 * hstep;
    const unsigned ldsw = (unsigned)wid * 1024u;
    const int aoff = lds_byte(wr * 64 + fr, fq * 8), boff = lds_byte(wc * 32 + fr, fq * 8);
#define PG8_SA(b, h) (((b) * 2 + (h)) * HTB)
#define PG8_SB(b, h) ((4 + (b) * 2 + (h)) * HTB)
#define PG8_STAGE(bufoff, gbase, voff) do { _Pragma("unroll") for (int _i = 0; _i < 2; ++_i) \
        __builtin_amdgcn_global_load_lds((const unsigned*)((const char*)(gbase) + (voff)[_i]), (PG8_LAS unsigned*)(lds + (bufoff) + ldsw + _i * 8192), 16, 0, 0); } while (0)
#define PG8_LDA(dst, b, h) do { _Pragma("unroll") for (int m = 0; m < 4; ++m) _Pragma("unroll") for (int k = 0; k < 2; ++k) dst[m][k] = *(const PG8_LAS bf16x8*)(lds + PG8_SA(b, h) + aoff + m * 2048 + k * 1024); } while (0)
#define PG8_LDB(dst, b, h) do { _Pragma("unroll") for (int n = 0; n < 2; ++n) _Pragma("unroll") for (int k = 0; k < 2; ++k) dst[n][k] = *(const PG8_LAS bf16x8*)(lds + PG8_SB(b, h) + boff + n * 2048 + k * 1024); } while (0)
#define PG8_MMA(ai, bj, At, Bt) do { __builtin_amdgcn_s_setprio(1); _Pragma("unroll") for (int m = 0; m < 4; ++m) _Pragma("unroll") for (int n = 0; n < 2; ++n) _Pragma("unroll") for (int k = 0; k < 2; ++k) \
        acc[ai][bj][m][n] = __builtin_amdgcn_mfma_f32_16x16x32_bf16(Bt[n][k], At[m][k], acc[ai][bj][m][n], 0, 0, 0); __builtin_amdgcn_s_setprio(0); } while (0)
#define PG8_WAIT_V(n) asm volatile("s_waitcnt vmcnt(" #n ")" ::: "memory")
#define PG8_WAIT_L(n) asm volatile("s_waitcnt lgkmcnt(" #n ")" ::: "memory")
#define PG8_BAR __builtin_amdgcn_s_barrier()
#define PG8_SCHED __builtin_amdgcn_sched_barrier(0)
    Unit cur, nxt; int ui = 0;
    if (!S.next(0, cur)) return;
    f32x4 acc[2][2][4][2];
#pragma unroll
    for (int a = 0; a < 2; ++a)
#pragma unroll
        for (int b = 0; b < 2; ++b)
#pragma unroll
            for (int m = 0; m < 4; ++m)
#pragma unroll
                for (int n = 0; n < 2; ++n) acc[a][b][m][n] = (f32x4){0.f, 0.f, 0.f, 0.f};
    bf16x8 At[4][2], B0[2][2], B1[2][2];
    const char* cA = (const char*)g.A + (size_t)cur.pm * tstep; const char* cB = (const char*)g.Bt + (size_t)cur.pn * tstep;
    S.a_ready(cur);
    if constexpr (SP2) {
        PG8_STAGE(PG8_SB(0, 0), cB, voffB); PG8_STAGE(PG8_SB(0, 1), cB + hstep, voffB); PG8_STAGE(PG8_SA(0, 0), cA, voffA); PG8_STAGE(PG8_SA(0, 1), cA + hstep, voffA);
        if (wr == 1) PG8_BAR;
        PG8_WAIT_V(2); PG8_BAR;
        PG8_STAGE(PG8_SB(1, 0), cB + kstep, voffB); PG8_STAGE(PG8_SA(1, 0), cA + kstep, voffA); PG8_STAGE(PG8_SB(1, 1), cB + hstep + kstep, voffB);
        PG8_WAIT_V(6); PG8_BAR;
    } else {
        PG8_STAGE(PG8_SB(0, 0), cB, voffB); PG8_STAGE(PG8_SA(0, 0), cA, voffA); PG8_STAGE(PG8_SB(0, 1), cB + hstep, voffB); PG8_STAGE(PG8_SA(0, 1), cA + hstep, voffA);
        if (wr == 1) PG8_BAR;
        PG8_WAIT_V(4); PG8_BAR;
        PG8_STAGE(PG8_SB(1, 0), cB + kstep, voffB); PG8_STAGE(PG8_SA(1, 0), cA + kstep, voffA); PG8_STAGE(PG8_SB(1, 1), cB + hstep + kstep, voffB);
        PG8_WAIT_V(6); PG8_BAR;
    }
    for (;;) {
        const bool has_next = S.next(ui + 1, nxt);
        const char* nA = has_next ? (const char*)g.A + (size_t)nxt.pm * tstep : cA; const char* nB = has_next ? (const char*)g.Bt + (size_t)nxt.pn * tstep : cB;
        for (int t = 0; t < nt; t += 2) {
            const bool last = (t == nt - 2);
            const char* a1 = cA + (size_t)(t + 1) * kstep;
            const char* a2 = last ? nA : cA + (size_t)(t + 2) * kstep; const char* b2 = last ? nB : cB + (size_t)(t + 2) * kstep;
            const char* a3 = a2 + kstep; const char* b3 = b2 + kstep;
            if (last && has_next) S.a_ready(nxt);
            if constexpr (SP2) {
            PG8_LDB(B0, 0, 0); PG8_LDB(B1, 0, 1); PG8_SCHED; PG8_LDA(At, 0, 0); PG8_STAGE(PG8_SA(1, 1), a1 + hstep, voffA);
            PG8_WAIT_V(8); PG8_WAIT_L(0); PG8_BAR; PG8_MMA(0, 0, At, B0); PG8_MMA(0, 1, At, B1); PG8_BAR; PG8_SCHED;
            PG8_LDA(At, 0, 1); PG8_STAGE(PG8_SB(0, 0), b2, voffB); PG8_STAGE(PG8_SB(0, 1), b2 + hstep, voffB); PG8_STAGE(PG8_SA(0, 0), a2, voffA);
            PG8_WAIT_V(8); PG8_WAIT_L(0); PG8_BAR; PG8_MMA(1, 0, At, B0); PG8_MMA(1, 1, At, B1); PG8_BAR; PG8_SCHED;
            PG8_LDB(B0, 1, 0); PG8_LDB(B1, 1, 1); PG8_SCHED; PG8_LDA(At, 1, 0); PG8_STAGE(PG8_SA(0, 1), a2 + hstep, voffA);
            PG8_WAIT_V(8); PG8_WAIT_L(0); PG8_BAR; PG8_MMA(0, 0, At, B0); PG8_MMA(0, 1, At, B1); PG8_BAR; PG8_SCHED;
            PG8_LDA(At, 1, 1); PG8_STAGE(PG8_SB(1, 0), b3, voffB); PG8_STAGE(PG8_SB(1, 1), b3 + hstep, voffB); PG8_STAGE(PG8_SA(1, 0), a3, voffA);
            PG8_WAIT_V(8); PG8_WAIT_L(0); PG8_BAR; PG8_MMA(1, 0, At, B0); PG8_MMA(1, 1, At, B1); PG8_BAR; PG8_SCHED;
            } else {
            PG8_LDB(B0, 0, 0); PG8_SCHED; PG8_LDA(At, 0, 0); PG8_STAGE(PG8_SA(1, 1), a1 + hstep, voffA);
            PG8_WAIT_L(8); PG8_BAR; PG8_WAIT_L(0); PG8_MMA(0, 0, At, B0); PG8_BAR; PG8_SCHED;
            PG8_LDB(B1, 0, 1); PG8_STAGE(PG8_SB(0, 0), b2, voffB);
            PG8_BAR; PG8_WAIT_L(0); PG8_MMA(0, 1, At, B1); PG8_BAR;
            PG8_LDA(At, 0, 1); PG8_STAGE(PG8_SA(0, 0), a2, voffA);
            PG8_BAR; PG8_WAIT_L(0); PG8_MMA(1, 0, At, B0); PG8_BAR; PG8_SCHED;
            PG8_STAGE(PG8_SB(0, 1), b2 + hstep, voffB);
            PG8_WAIT_V(6); PG8_BAR; PG8_MMA(1, 1, At, B1); PG8_BAR;
            PG8_LDB(B0, 1, 0); PG8_SCHED; PG8_LDA(At, 1, 0); PG8_STAGE(PG8_SA(0, 1), a2 + hstep, voffA);
            PG8_WAIT_L(8); PG8_BAR; PG8_WAIT_L(0); PG8_MMA(0, 0, At, B0); PG8_BAR; PG8_SCHED;
            PG8_LDB(B1, 1, 1); PG8_STAGE(PG8_SB(1, 0), b3, voffB);
            PG8_BAR; PG8_WAIT_L(0); PG8_MMA(0, 1, At, B1); PG8_BAR;
            PG8_LDA(At, 1, 1); PG8_STAGE(PG8_SA(1, 0), a3, voffA);
            PG8_BAR; PG8_WAIT_L(0); PG8_MMA(1, 0, At, B0); PG8_BAR; PG8_SCHED;
            PG8_STAGE(PG8_SB(1, 1), b3 + hstep, voffB);
            PG8_WAIT_V(6); PG8_BAR; PG8_MMA(1, 1, At, B1); PG8_BAR;
            }
        }
        if constexpr (ALIGN_EPI) { if (wr == 0) PG8_BAR; }
        if constexpr (!Epi::AFTER_DRAIN) { E(acc, cur, wr, wc, fr, fq); S.done(cur); }
        if (!has_next) break;
#pragma unroll
        for (int a = 0; a < 2; ++a)
#pragma unroll
            for (int b = 0; b < 2; ++b)
#pragma unroll
                for (int m = 0; m < 4; ++m)
#pragma unroll
                    for (int n = 0; n < 2; ++n) acc[a][b][m][n] = (f32x4){0.f, 0.f, 0.f, 0.f};
        cur = nxt; cA = nA; cB = nB; ++ui;
        if constexpr (ALIGN_EPI) { if (wr == 1) PG8_BAR; }
    }
    PG8_WAIT_V(0);
    if constexpr (!ALIGN_EPI) { if (wr == 0) PG8_BAR; }
    PG8_BAR;
    if constexpr (Epi::AFTER_DRAIN) { E.fused(acc, cur, wr, wc, fr, fq, lds, wid, lane); S.done(cur); }
#undef PG8_SA
#undef PG8_SB
#undef PG8_STAGE
#undef PG8_LDA
#undef PG8_LDB
#undef PG8_MMA
#undef PG8_WAIT_V
#undef PG8_WAIT_L
#undef PG8_BAR
#undef PG8_SCHED
}
}
#include <hip/hip_bf16.h>
#include <cmath>
namespace attn_body {
using bf16=__hip_bfloat16;
using bf16x8=__attribute__((ext_vector_type(8)))short;
using s16x4=__attribute__((ext_vector_type(4)))short;
using f32x16=__attribute__((ext_vector_type(16)))float;
using u32x4=__attribute__((ext_vector_type(4)))unsigned;
constexpr int SEQ=16384,D=64,DM=1024;
constexpr int NW=8,QBLK=32,QB=QBLK*NW,KVBLK=64,NQB=SEQ/QB;
constexpr int ATTN_PITCH=DM, ATTN_UNIT_ROWS=QB;
__device__ __forceinline__ int crow(int r,int hi){return (r&3)+8*(r>>2)+4*hi;}
#define SBAR() __builtin_amdgcn_sched_barrier(0)
__device__ __forceinline__ void cmask(f32x16&p0,f32x16&p1,int jb,int qrel,int hi){
  const float NEG=-INFINITY; int kb=64*jb+4*hi;
  #pragma unroll
  for(int r=0;r<16;++r){int kv=kb+(r&3)+8*(r>>2); if(kv>qrel)p0[r]=NEG; if(kv+32>qrel)p1[r]=NEG;}
}

constexpr int NSLOT=3, SLOTB=8192;
constexpr int LDS_K=0, LDS_V=NSLOT*SLOTB, LDS_WS=NSLOT*SLOTB+NSLOT*2*SLOTB, LDS_QF=LDS_WS+NW*64*4, LDS_OST=0, LDS_BYTES=LDS_QF+NW*4096;
constexpr float C2=0.125f*1.4426950408889634f;
__device__ __forceinline__ void glds16(const void*gsrc,unsigned lds_dst){unsigned keep;
  asm volatile("s_mov_b32 %0, m0\n\ts_mov_b32 m0, %2\n\ts_nop 0\n\tglobal_load_lds_dwordx4 %1, off\n\ts_mov_b32 m0, %0":"=&s"(keep):"v"(gsrc),"s"(lds_dst):"memory");}
__device__ __forceinline__ void glds16s(const void*sbase,unsigned voff,unsigned lds_dst){unsigned keep;
  asm volatile("s_mov_b32 %0, m0\n\ts_mov_b32 m0, %3\n\ts_nop 0\n\tglobal_load_lds_dwordx4 %1, %2\n\ts_mov_b32 m0, %0":"=&s"(keep):"v"(voff),"s"(sbase),"s"(lds_dst):"memory");}
__device__ __forceinline__ float max3f(float a,float b,float c){float r;asm("v_max3_f32 %0, %1, %2, %3":"=v"(r):"v"(a),"v"(b),"v"(c));return r;}
__device__ __forceinline__ float max2f(float a,float b){float r;asm("v_max_f32_e32 %0, %1, %2":"=v"(r):"v"(a),"v"(b));return r;}
__device__ __forceinline__ float fadd_s(float a,float b){float r;asm("v_add_f32_e32 %0, %1, %2":"=v"(r):"v"(a),"v"(b));return r;}
__device__ __forceinline__ float fsub_s(float a,float b){float r;asm("v_sub_f32_e32 %0, %1, %2":"=v"(r):"v"(a),"v"(b));return r;}
typedef float f32x2_t __attribute__((ext_vector_type(2))); typedef __bf16 bf16x2_t __attribute__((ext_vector_type(2)));
__device__ __forceinline__ unsigned cvtpk_s(float lo,float hi){f32x2_t v={lo,hi};bf16x2_t b=__builtin_convertvector(v,bf16x2_t);return __builtin_bit_cast(unsigned,b);}
#define WAIT_BAR(N) asm volatile("s_waitcnt vmcnt(" #N ") lgkmcnt(0)\n\ts_barrier":::"memory")

__device__ __forceinline__ void qkt(f32x16&p0,f32x16&p1,const char*Kslot,const bf16x8*qr,const f32x16&negm,int r32,int hi){
  const char*kb=Kslot+hi*1024+r32*16;
  #pragma unroll
  for(int d0=0;d0<4;++d0){
    const bf16x8 b0=*reinterpret_cast<const bf16x8*>(kb+d0*2048);
    const bf16x8 b1=*reinterpret_cast<const bf16x8*>(kb+d0*2048+512);
    if(d0==0){p0=__builtin_amdgcn_mfma_f32_32x32x16_bf16(b0,qr[0],negm,0,0,0);p1=__builtin_amdgcn_mfma_f32_32x32x16_bf16(b1,qr[0],negm,0,0,0);}
    else{p0=__builtin_amdgcn_mfma_f32_32x32x16_bf16(b0,qr[d0],p0,0,0,0);p1=__builtin_amdgcn_mfma_f32_32x32x16_bf16(b1,qr[d0],p1,0,0,0);}}
}
typedef __attribute__((address_space(3))) const char* lds_cptr;
typedef short v4i16_t __attribute__((ext_vector_type(4)));
__device__ __forceinline__ void kload8(bf16x8*kf,lds_cptr kp){
  kf[0]=*(const __attribute__((address_space(3))) bf16x8*)(kp);      kf[1]=*(const __attribute__((address_space(3))) bf16x8*)(kp+512);
  kf[2]=*(const __attribute__((address_space(3))) bf16x8*)(kp+2048); kf[3]=*(const __attribute__((address_space(3))) bf16x8*)(kp+2560);
  kf[4]=*(const __attribute__((address_space(3))) bf16x8*)(kp+4096); kf[5]=*(const __attribute__((address_space(3))) bf16x8*)(kp+4608);
  kf[6]=*(const __attribute__((address_space(3))) bf16x8*)(kp+6144); kf[7]=*(const __attribute__((address_space(3))) bf16x8*)(kp+6656);
}
__device__ __forceinline__ void kload2(bf16x8*kf,lds_cptr kp,int j){ kf[2*j]=*(const __attribute__((address_space(3))) bf16x8*)(kp+j*2048); kf[2*j+1]=*(const __attribute__((address_space(3))) bf16x8*)(kp+j*2048+512); }
__device__ __forceinline__ s16x4 vtr(lds_cptr p){ return __builtin_bit_cast(s16x4,__builtin_amdgcn_ds_read_tr16_b64_v4i16((__attribute__((address_space(3))) v4i16_t*)p)); }
__device__ __forceinline__ float rowmax(const f32x16&p0,const f32x16&p1){
  float a=max3f(p0[0],p0[1],p1[0]),b=max3f(p0[2],p0[3],p1[1]);a=max3f(a,p1[2],p1[3]);
  #pragma unroll
  for(int r=4;r<16;r+=4){a=max3f(a,p0[r],p0[r+1]);b=max3f(b,p0[r+2],p0[r+3]);a=max3f(a,p1[r],p1[r+1]);b=max3f(b,p1[r+2],p1[r+3]);}
  const float m=max2f(a,b);
  auto rr=__builtin_amdgcn_permlane32_swap(__float_as_uint(m),__float_as_uint(m),false,false);
  return max2f(__uint_as_float(rr[0]),__uint_as_float(rr[1]));
}
__device__ __forceinline__ void pv(f32x16*o,int vb,bf16x8 pa0,bf16x8 pa1,bf16x8 pa2,bf16x8 pa3){
  #pragma unroll
  for(int d0=0;d0<4;++d0){s16x4 lo[4],hi[4];
    #pragma unroll
    for(int ks=0;ks<4;++ks){
      asm volatile("ds_read_b64_tr_b16 %0,%1 offset:%c2":"=&v"(lo[ks]):"v"(vb),"i"((d0&1)*4096+(d0>>1)*8192+ks*1024):"memory");
      asm volatile("ds_read_b64_tr_b16 %0,%1 offset:%c2":"=&v"(hi[ks]):"v"(vb),"i"((d0&1)*4096+(d0>>1)*8192+ks*1024+512):"memory");}
    asm volatile("s_waitcnt lgkmcnt(0)":::"memory");SBAR();
    #define PK(k) (bf16x8){lo[k][0],lo[k][1],lo[k][2],lo[k][3],hi[k][0],hi[k][1],hi[k][2],hi[k][3]}
    o[d0]=__builtin_amdgcn_mfma_f32_32x32x16_bf16(pa0,PK(0),o[d0],0,0,0);
    o[d0]=__builtin_amdgcn_mfma_f32_32x32x16_bf16(pa1,PK(1),o[d0],0,0,0);
    o[d0]=__builtin_amdgcn_mfma_f32_32x32x16_bf16(pa2,PK(2),o[d0],0,0,0);
    o[d0]=__builtin_amdgcn_mfma_f32_32x32x16_bf16(pa3,PK(3),o[d0],0,0,0);
    #undef PK
  }
}

#ifndef ATTN_STORE16
#define ATTN_STORE16(p,v) (*(u32x4*)(p)=(v))
#endif
template<int THRL> __device__ __forceinline__ void attn_unit(int qb,int t0,float sl2,const bf16*Qh,const bf16*__restrict__ Kh0,const bf16*__restrict__ Vh0,bf16*Oh,char*shm){
  int tid_o=threadIdx.x; asm volatile("":"+v"(tid_o)); const int tid=tid_o,lane=tid&63,r32=lane&31,hi=lane>>5; const int wid=__builtin_amdgcn_readfirstlane(tid>>6);
  const int q0=qb*QB;
  const bf16*Qw=Qh+(long)(q0+wid*QBLK)*DM;
  const bf16*Kh=Kh0+(long)t0*KVBLK*DM,*Vh=Vh0+(long)t0*KVBLK*DM;
  const unsigned lds0=(unsigned)(uintptr_t)shm;
  float*wsf=(float*)(shm+LDS_WS)+wid*64;
  const unsigned kvo=(unsigned)(lane*DM+wid*8)*2u;
  const unsigned vvo=(unsigned)((16*(wid&3)+(lane>>2))*DM+(wid>>2)*32+(lane&3)*8)*2u;
  const unsigned kdst=lds0+LDS_K+wid*1024, vdst=lds0+LDS_V+wid*1024;
  #define DMA_K(t,slot) glds16s(Kh+(long)(t)*KVBLK*DM,kvo,(unsigned)__builtin_amdgcn_readfirstlane(kdst+(slot)))
  #define DMA_V(t,slot) do{ glds16s(Vh+(long)(t)*KVBLK*DM,vvo,(unsigned)__builtin_amdgcn_readfirstlane(vdst+2*(slot))); glds16s(Vh+64+(long)(t)*KVBLK*DM,vvo,(unsigned)__builtin_amdgcn_readfirstlane(vdst+2*(slot)+8192)); }while(0)
  #define VB0 ((int)(lds0+LDS_V)+((lane>>4)&1)*32+(lane&3)*8+(4*hi+((lane&15)>>2))*64)
  const char*Kbase=shm+LDS_K; bf16x8 kf[8];
  const lds_cptr shm3=(lds_cptr)shm; const lds_cptr kp0=shm3+LDS_K+hi*1024+r32*16; const lds_cptr vp0=shm3+LDS_V+((lane>>4)&1)*32+(lane&3)*8+(4*hi+((lane&15)>>2))*64;
  const int NT=(q0+QB)/KVBLK-t0;
  DMA_K(0,0);DMA_V(0,0);DMA_K(1,SLOTB);
  bf16x8 qr[4];
  #pragma unroll
  for(int d0=0;d0<4;++d0)qr[d0]=*reinterpret_cast<const bf16x8*>(&Qw[(long)r32*DM+d0*16+hi*8]);
  lds_cptr qfp=(lds_cptr)shm+LDS_QF+wid*4096+lane*16;
  #pragma unroll
  for(int d0=0;d0<4;++d0)*(__attribute__((address_space(3))) bf16x8*)(qfp+d0*1024)=qr[d0];
  asm volatile("":"+v"(qfp));
  float mhat=0.f,l_reg=0.f;f32x16 o[4];o[0]=f32x16{};o[1]=f32x16{};o[2]=f32x16{};o[3]=f32x16{};f32x16 negm=f32x16{};asm volatile("":"+v"(negm)); float nb=0.f;
  const int qrel=wid*QBLK+r32;
  const float sl32=32.f*sl2, sl64=64.f*sl2; const float bt0=sl2*(float)(64*t0+4*hi-(q0+qrel));
  #define CMASK(P0,P1,t) do{int jb_=(t)-(NT-4); if(jb_>=0)cmask(P0,P1,jb_,qrel,hi);}while(0)
  bool resc=false;
  #define START(P0,P1) do{ const float rm=rowmax(P0,P1); resc=false; \
    { const float dl=rm; mhat=fadd_s(mhat,dl); \
      _Pragma("unroll") for(int r=0;r<16;++r){P0[r]=fsub_s(P0[r],dl);P1[r]=fsub_s(P1[r],dl);} \
      nb=bt0+sl64-mhat; } \
    _Pragma("unroll") for(int r=0;r<16;++r)P0[r]=__builtin_amdgcn_exp2f(P0[r]); }while(0)
  #define RESC() do{ if(resc){ asm volatile("s_waitcnt lgkmcnt(0)":::"memory"); \
      _Pragma("unroll") for(int d_=0;d_<4;++d_) _Pragma("unroll") for(int r=0;r<16;++r)o[d_][r]*=wsf[crow(r,hi)]; } }while(0)
  f32x16 pA0,pA1,pB0,pB1;
  int sl_prev=0,sl_cur=0,sl_next=SLOTB;
  #define ROT() do{sl_prev=sl_cur;sl_cur=sl_next;sl_next=(sl_next==(NSLOT-1)*SLOTB)?0:sl_next+SLOTB;}while(0)
  DMA_K(2,2*SLOTB);
  WAIT_BAR(4);
  qkt(pA0,pA1,Kbase,qr,negm,r32,hi);asm volatile("s_nop 15\n\ts_nop 7":"+v"(pA0),"+v"(pA1));
  _Pragma("unroll") for(int r=0;r<16;++r){const float bb=bt0+sl2*(float)((r&3)+8*(r>>2)); pA0[r]+=bb; pA1[r]+=bb+sl32;}
  CMASK(pA0,pA1,0);
  START(pA0,pA1);
  _Pragma("unroll") for(int r=0;r<16;++r)pA1[r]=__builtin_amdgcn_exp2f(pA1[r]);
  WAIT_BAR(0);
  DMA_K(3,0);DMA_V(1,SLOTB);
  ROT();
  kload8(kf,kp0+sl_cur);
  WAIT_BAR(3);
  s16x4 vlo[8],vhi[8]; u32x4 pw0,pw1,pw2,pw3;
  #define PKW(P,B) cvtpk_s(P[B],P[B+1])
  #define PAF(k) __builtin_bit_cast(bf16x8,pw##k)
  #define VFR(i) (bf16x8){vlo[i][0],vlo[i][1],vlo[i][2],vlo[i][3],vhi[i][0],vhi[i][1],vhi[i][2],vhi[i][3]}
  #define PIN(x) asm volatile("":"+v"(x))
  #define MX3(a,b,c) __builtin_fmaxf(__builtin_fmaxf((a),(b)),(c))
  #define GAPA(MF,A0,A1,A2,A3,W0,W1,PW) do{ MF; sacc+=A0; sacc+=A1; sacc+=A2; sacc+=A3; PIN(sacc); W0; W1; PIN(PW); SBAR(); }while(0)
  #define EX(v) __builtin_amdgcn_exp2f(v)
  #define GAPB(MF,X,B) do{ MF; X[B]=EX(X[B]); X[B+1]=EX(X[B+1]); X[B+2]=EX(X[B+2]); X[B+3]=EX(X[B+3]); PIN(X); SBAR(); }while(0)
  #define VRD(i) do{ vlo[i]=vtr(vp_+(((i)>>2)*4096+((i)&3)*1024)); vhi[i]=vtr(vp_+(((i)>>2)*4096+((i)&3)*1024+512)); }while(0)
  #define VRD2(i) do{ vlo[i]=vtr(vp_+(8192+((i)>>2)*4096+((i)&3)*1024)); vhi[i]=vtr(vp_+(8192+((i)>>2)*4096+((i)&3)*1024+512)); }while(0)
  #define KRD(G,j) do{ if(G){ kload2(kf,kp0+sl_next,j); SBAR(); } }while(0)
  #define STEP(C0,C1,P0,P1,t,GK,GV,GL) do{ SBAR(); \
    const lds_cptr vp_=vp0+2*sl_prev; \
    float sacc=(P0[0]+P0[1]); \
    f32x16 tn_; _Pragma("unroll") for(int r=0;r<16;++r)tn_[r]=nb+sl2*(float)((r&3)+8*(r>>2)); \
    bf16x8 ql_[4]; ql_[0]=*(const __attribute__((address_space(3))) bf16x8*)(qfp); ql_[1]=*(const __attribute__((address_space(3))) bf16x8*)(qfp+1024); \
    GAPA(C0=__builtin_amdgcn_mfma_f32_32x32x16_bf16(kf[0],ql_[0],tn_,0,0,0), P0[2],P0[3],P0[4],P0[5],     pw0[0]=PKW(P0,0), pw0[1]=PKW(P0,2), pw0); \
    GAPA(C1=__builtin_amdgcn_mfma_f32_32x32x16_bf16(kf[1],ql_[0],tn_,0,0,0), P0[6],P0[7],P0[8],P0[9],     pw0[2]=PKW(P0,4), pw0[3]=PKW(P0,6), pw0); \
    ql_[2]=*(const __attribute__((address_space(3))) bf16x8*)(qfp+2048); \
    GAPA(C0=__builtin_amdgcn_mfma_f32_32x32x16_bf16(kf[2],ql_[1],C0,0,0,0),   P0[10],P0[11],P0[12],P0[13], pw1[0]=PKW(P0,8), pw1[1]=PKW(P0,10), pw1); \
    GAPA(C1=__builtin_amdgcn_mfma_f32_32x32x16_bf16(kf[3],ql_[1],C1,0,0,0),   P0[14],P0[15],P1[0],P1[1],   pw1[2]=PKW(P0,12),pw1[3]=PKW(P0,14), pw1); \
    ql_[3]=*(const __attribute__((address_space(3))) bf16x8*)(qfp+3072); \
    GAPA(C0=__builtin_amdgcn_mfma_f32_32x32x16_bf16(kf[4],ql_[2],C0,0,0,0),   P1[2],P1[3],P1[4],P1[5],     pw2[0]=PKW(P1,0), pw2[1]=PKW(P1,2), pw2); \
    GAPA(C1=__builtin_amdgcn_mfma_f32_32x32x16_bf16(kf[5],ql_[2],C1,0,0,0),   P1[6],P1[7],P1[8],P1[9],     pw2[2]=PKW(P1,4), pw2[3]=PKW(P1,6), pw2); \
    VRD(0);VRD(4); SBAR(); \
    GAPA(C0=__builtin_amdgcn_mfma_f32_32x32x16_bf16(kf[6],ql_[3],C0,0,0,0),   P1[10],P1[11],P1[12],P1[13], pw3[0]=PKW(P1,8), pw3[1]=PKW(P1,10), pw3); \
    VRD(1);VRD(5); SBAR(); \
    GAPA(C1=__builtin_amdgcn_mfma_f32_32x32x16_bf16(kf[7],ql_[3],C1,0,0,0),   P1[14],P1[15],0.f,0.f,       pw3[2]=PKW(P1,12),pw3[3]=PKW(P1,14), pw3); \
    l_reg+=sacc; \
    if(GK){DMA_K((t)+3,sl_cur);} if(GV){DMA_V((t)+1,sl_next);} \
    _Pragma("unroll") for(int r=0;r<16;++r){C1[r]+=sl32;} nb+=sl64; \
    CMASK(C0,C1,t); \
    { float a=MX3(C0[0],C0[1],C1[0]),b=MX3(C0[2],C0[3],C1[1]); a=MX3(a,C1[2],C1[3]); \
      _Pragma("unroll") for(int r=4;r<16;r+=4){a=MX3(a,C0[r],C0[r+1]);b=MX3(b,C0[r+2],C0[r+3]);a=MX3(a,C1[r],C1[r+1]);b=MX3(b,C1[r+2],C1[r+3]);} \
      float rm=__builtin_fmaxf(a,b); { auto rr=__builtin_amdgcn_permlane32_swap(__float_as_uint(rm),__float_as_uint(rm),false,false); rm=__builtin_fmaxf(__uint_as_float(rr[0]),__uint_as_float(rr[1])); } \
      resc=false; \
      if(__builtin_expect(__any(rm>(float)THRL),0)){ const float dl=__builtin_fmaxf(rm,0.f); mhat+=dl; \
        _Pragma("unroll") for(int r=0;r<16;++r){C0[r]-=dl;C1[r]-=dl;} \
        nb-=dl; \
        const float f=__builtin_amdgcn_exp2f(-dl); l_reg*=f; if(hi==0)wsf[r32]=f; resc=true; } } \
    SBAR(); \
    asm volatile("s_waitcnt lgkmcnt(0)":::"memory"); SBAR(); \
    GAPB(o[0]=__builtin_amdgcn_mfma_f32_32x32x16_bf16(PAF(0),VFR(0),o[0],0,0,0), C0,0); \
    GAPB(o[1]=__builtin_amdgcn_mfma_f32_32x32x16_bf16(PAF(0),VFR(4),o[1],0,0,0), C0,4); \
    KRD(GL,0); GAPB(o[0]=__builtin_amdgcn_mfma_f32_32x32x16_bf16(PAF(1),VFR(1),o[0],0,0,0), C0,8); \
    KRD(GL,1); GAPB(o[1]=__builtin_amdgcn_mfma_f32_32x32x16_bf16(PAF(1),VFR(5),o[1],0,0,0), C0,12); \
    VRD(2);VRD(6);VRD(3);VRD(7); asm volatile("s_waitcnt lgkmcnt(0)":::"memory"); SBAR(); \
    KRD(GL,2); GAPB(o[0]=__builtin_amdgcn_mfma_f32_32x32x16_bf16(PAF(2),VFR(2),o[0],0,0,0), C1,0); \
    KRD(GL,3); GAPB(o[1]=__builtin_amdgcn_mfma_f32_32x32x16_bf16(PAF(2),VFR(6),o[1],0,0,0), C1,4); \
    GAPB(o[0]=__builtin_amdgcn_mfma_f32_32x32x16_bf16(PAF(3),VFR(3),o[0],0,0,0), C1,8); \
    GAPB(o[1]=__builtin_amdgcn_mfma_f32_32x32x16_bf16(PAF(3),VFR(7),o[1],0,0,0), C1,12); \
    VRD2(0);VRD2(4);VRD2(1);VRD2(5); asm volatile("s_waitcnt lgkmcnt(0)":::"memory"); SBAR(); \
    o[2]=__builtin_amdgcn_mfma_f32_32x32x16_bf16(PAF(0),VFR(0),o[2],0,0,0); o[3]=__builtin_amdgcn_mfma_f32_32x32x16_bf16(PAF(0),VFR(4),o[3],0,0,0); \
    o[2]=__builtin_amdgcn_mfma_f32_32x32x16_bf16(PAF(1),VFR(1),o[2],0,0,0); o[3]=__builtin_amdgcn_mfma_f32_32x32x16_bf16(PAF(1),VFR(5),o[3],0,0,0); SBAR(); \
    VRD2(2);VRD2(6);VRD2(3);VRD2(7); asm volatile("s_waitcnt lgkmcnt(0)":::"memory"); SBAR(); \
    o[2]=__builtin_amdgcn_mfma_f32_32x32x16_bf16(PAF(2),VFR(2),o[2],0,0,0); o[3]=__builtin_amdgcn_mfma_f32_32x32x16_bf16(PAF(2),VFR(6),o[3],0,0,0); \
    o[2]=__builtin_amdgcn_mfma_f32_32x32x16_bf16(PAF(3),VFR(3),o[2],0,0,0); o[3]=__builtin_amdgcn_mfma_f32_32x32x16_bf16(PAF(3),VFR(7),o[3],0,0,0); SBAR(); \
    }while(0)
  int t=1;
  #undef CMASK
  #define CMASK(P0,P1,t) do{}while(0)
  for(;t+5<NT;t+=2){
    STEP(pB0,pB1,pA0,pA1,t,true,true,true);     WAIT_BAR(3); RESC(); ROT();
    STEP(pA0,pA1,pB0,pB1,t+1,true,true,true);   WAIT_BAR(3); RESC(); ROT();
  }
  #undef CMASK
  #define CMASK(P0,P1,t) do{int jb_=(t)-(NT-4); if(jb_>=0)cmask(P0,P1,jb_,qrel,hi);}while(0)
  #define ENDW(tt) do{ if((tt)+3<NT){WAIT_BAR(3);} else if((tt)+2<NT){WAIT_BAR(2);} else {WAIT_BAR(0);} }while(0)
  for(;t+1<NT;t+=2){
    STEP(pB0,pB1,pA0,pA1,t,(t+3<NT),(t+1<NT),(t+1<NT));       ENDW(t);   RESC(); ROT();
    STEP(pA0,pA1,pB0,pB1,t+1,(t+4<NT),(t+2<NT),(t+2<NT));     ENDW(t+1); RESC(); ROT();
  }
  STEP(pB0,pB1,pA0,pA1,NT-1,false,false,false); RESC();
  { float sacc=pB0[0]+pB0[1]; _Pragma("unroll") for(int r=2;r<16;++r)sacc+=pB0[r]; _Pragma("unroll") for(int r=0;r<16;++r)sacc+=pB1[r]; l_reg+=sacc;
    pw0=(u32x4){PKW(pB0,0),PKW(pB0,2),PKW(pB0,4),PKW(pB0,6)};pw1=(u32x4){PKW(pB0,8),PKW(pB0,10),PKW(pB0,12),PKW(pB0,14)};pw2=(u32x4){PKW(pB1,0),PKW(pB1,2),PKW(pB1,4),PKW(pB1,6)};pw3=(u32x4){PKW(pB1,8),PKW(pB1,10),PKW(pB1,12),PKW(pB1,14)};
    SBAR(); pv(o,VB0+2*sl_cur,PAF(0),PAF(1),PAF(2),PAF(3)); }
  #undef PKW
  #undef PAF
  #undef VFR
  #undef PIN
  #undef MX3
  #undef GAPA
  #undef GAPB
  #undef EX
  #undef VRD
  #undef VRD2
  #undef KRD
  #undef STEP
  #undef ENDW
  {auto rr=__builtin_amdgcn_permlane32_swap(__float_as_uint(l_reg),__float_as_uint(l_reg),false,false);l_reg=__uint_as_float(rr[0])+__uint_as_float(rr[1]);}
  if(hi==0)wsf[32+r32]=l_reg;asm volatile("s_waitcnt lgkmcnt(0)":::"memory");
  float rli[16];
  #pragma unroll
  for(int r=0;r<16;++r)rli[r]=__builtin_amdgcn_rcpf(wsf[32+crow(r,hi)]);
  bf16*Ow=Oh+(long)(q0+wid*QBLK)*DM;
  asm volatile("s_waitcnt lgkmcnt(0)\n\ts_barrier":::"memory");
  { bf16*stg=(bf16*)(shm+LDS_OST)+wid*4096;
    #pragma unroll
    for(int r=0;r<16;++r){const int orow=crow(r,hi);
      #pragma unroll
      for(int d0=0;d0<4;++d0)stg[orow*128+d0*32+r32]=__float2bfloat16(o[d0][r]*rli[r]);}
    asm volatile("s_waitcnt lgkmcnt(0)":::"memory");
    #pragma unroll
    for(int i=0;i<8;++i){const int row=i*4+(lane>>4),ch=lane&15; const u32x4 v=*(const u32x4*)(stg+row*128+ch*8); ATTN_STORE16(Ow+(long)row*DM+ch*8,v);} }
  asm volatile("s_waitcnt lgkmcnt(0)\n\ts_barrier":::"memory");
  #undef DMA_K
  #undef DMA_V
  #undef CMASK
  #undef START
  #undef RESC
  #undef ROT
}
constexpr int ATTN_LDS_BYTES=LDS_BYTES;
#undef SBAR
#undef WAIT_BAR
}
#define LAS __attribute__((address_space(3)))
#define DI __device__ __forceinline__
typedef unsigned short bfu;
typedef short bf16x8 __attribute__((ext_vector_type(8)));
typedef float f32x4 __attribute__((ext_vector_type(4)));
typedef unsigned u32x4 __attribute__((ext_vector_type(4)));
typedef unsigned u32x2 __attribute__((ext_vector_type(2)));
constexpr int T = 16384, D = 1024, FF = 2816;
constexpr float EPS = 1e-6f, LOG2E = 1.4426950408889634f;
constexpr size_t MiB = 1u << 20;
constexpr size_t WS_CTL = 8 * MiB;
constexpr size_t WS_STAT = 0, WS_SGSTAT = 1 * MiB, WS_RTSS = 4 * MiB, WS_LRAGG = 5 * MiB, WS_XB = 16 * MiB;
constexpr size_t WS_W1IN = 48 * MiB, WS_W1OUT = 59 * MiB, WS_W2IN = 65 * MiB, WS_W2OUT = 76 * MiB, WS_WMIN = 82 * MiB, WS_WMOUT = 94 * MiB, WS_WAX = 100 * MiB;
constexpr size_t WS_ACT = 104 * MiB, WS_SR = 296 * MiB, WS_END = 424 * MiB;
constexpr int LDS_BYTES = 160 * 1024;

DI float bf2f(unsigned h) { return __uint_as_float(h << 16); }
DI unsigned f2bf(float f) { unsigned u = __float_as_uint(f); return (u + 0x7fffu + ((u >> 16) & 1u)) >> 16; }
DI unsigned pk2(float lo, float hi) { return f2bf(lo) | (f2bf(hi) << 16); }
DI float sigmoidf_(float y) { return __builtin_amdgcn_rcpf(1.0f + __builtin_amdgcn_exp2f(-y * LOG2E)); }
DI float gelu_tanh(float x) { return x * sigmoidf_(1.5957691216057308f * (x + 0.044715f * x * x * x)); }
DI float wave_sum(float v) {
#pragma unroll
    for (int o = 1; o < 64; o <<= 1) v += __shfl_xor(v, o);
    return v;
}
#define LDS_WAIT() asm volatile("s_waitcnt lgkmcnt(0)" ::: "memory")

struct CvItem { const float* src; const float* gain; bfu* dst; int K, N, k0, gmask; float gsc; };
DI void cv_make(CvItem& o, int item, const float* W, int K, int N, bfu* WT, int MAP, const float* gain, int gmask, float gsc) {
    const int nblk = N / 32, kb = item / nblk, nb = item % nblk; const int drow0 = 32 * nb; int scol0 = drow0;
    if (MAP == 1) { const int pn = drow0 >> 8, bj = (drow0 >> 7) & 1, j0 = drow0 & 127; scol0 = bj * (N / 2) + 128 * pn + j0; }
    if (MAP == 2 && drow0 < 2048) { const int pn = drow0 >> 8, bj = (drow0 >> 7) & 1, wc = (drow0 >> 5) & 3; scol0 = 256 * pn + 64 * wc + 32 * bj; }
    o.src = W + (size_t)(64 * kb) * N + scol0; o.gain = gain; o.dst = WT + (size_t)drow0 * K + 64 * kb; o.K = K; o.N = N; o.k0 = 64 * kb; o.gmask = gmask; o.gsc = gsc;
}
DI void cv_load(const CvItem& it, f32x4 (&v)[8], float (&g)[8], int lane) {
#pragma unroll
    for (int i = 0; i < 8; ++i) { const int r = 8 * i + (lane >> 3); v[i] = *(const f32x4*)(it.src + (size_t)r * it.N + 4 * (lane & 7)); g[i] = it.gain ? it.gain[(it.k0 + r) & it.gmask] * it.gsc : 1.0f; }
}
DI void cv_store(const CvItem& it, const f32x4 (&v)[8], const float (&g)[8], LAS float* scr, int lane) {
#pragma unroll
    for (int i = 0; i < 8; ++i) { const int r = 8 * i + (lane >> 3); LAS float* p = scr + r * 33 + 4 * (lane & 7); p[0] = v[i][0] * g[i]; p[1] = v[i][1] * g[i]; p[2] = v[i][2] * g[i]; p[3] = v[i][3] * g[i]; }
    LDS_WAIT(); asm volatile("" ::: "memory");
    const int c = lane & 7;
#pragma unroll
    for (int j = 0; j < 4; ++j) { const int n = (lane >> 3) + 8 * j; const LAS float* s = scr + (8 * c) * 33 + n;
        u32x4 o; o.x = pk2(s[0 * 33], s[1 * 33]); o.y = pk2(s[2 * 33], s[3 * 33]); o.z = pk2(s[4 * 33], s[5 * 33]); o.w = pk2(s[6 * 33], s[7 * 33]);
        *(u32x4*)(it.dst + (size_t)n * it.K + 8 * c) = o; }
    LDS_WAIT(); asm volatile("" ::: "memory");
}
template <int MT, int NT> DI void wave_mma(f32x4 (&acc)[MT][NT], const LAS bfu* A, int lda, const LAS bfu* B, int ldb, int K, int fr, int fq) {
    for (int k0 = 0; k0 < K; k0 += 32) {
        bf16x8 a[MT];
#pragma unroll
        for (int mi = 0; mi < MT; ++mi) a[mi] = *(const LAS bf16x8*)(A + (16 * mi + fr) * lda + k0 + 8 * fq);
#pragma unroll
        for (int ni = 0; ni < NT; ++ni) { const bf16x8 b = *(const LAS bf16x8*)(B + (16 * ni + fr) * ldb + k0 + 8 * fq);
#pragma unroll
            for (int mi = 0; mi < MT; ++mi) acc[mi][ni] = __builtin_amdgcn_mfma_f32_16x16x32_bf16(a[mi], b, acc[mi][ni], 0, 0, 0); }
    }
}
#define LDS_BARRIER() asm volatile("s_waitcnt lgkmcnt(0)\n\ts_barrier" ::: "memory")
template <int NIT> DI void rows_load(u32x4 (&v)[NIT], const bfu* src, size_t gp, int C8, int tid) {
#pragma unroll
    for (int k = 0; k < NIT; ++k) { const int i = tid + 512 * k, r = i / C8, c = i - r * C8; v[k] = *(const u32x4*)(src + (size_t)r * gp + c * 8); }
}
template <int NIT> DI void rows_store(LAS bfu* dst, int LS, const u32x4 (&v)[NIT], int C8, int tid) {
#pragma unroll
    for (int k = 0; k < NIT; ++k) { const int i = tid + 512 * k, r = i / C8, c = i - r * C8; *(LAS u32x4*)(dst + r * LS + c * 8) = v[k]; }
}
template <int NIT> DI void T_load(u32x4 (&v)[NIT], const bfu* src, size_t gp, int R, int tid) {
#pragma unroll
    for (int k = 0; k < NIT; ++k) { const int i = tid + 512 * k, r = i & (R - 1), c8 = i / R; v[k] = *(const u32x4*)(src + (size_t)r * gp + c8 * 8); }
}
template <int NIT> DI void T_store(LAS bfu* dst, int LS, const u32x4 (&v)[NIT], int R, int tid, bool zeta, float lg) {
#pragma unroll
    for (int k = 0; k < NIT; ++k) { const int i = tid + 512 * k, r = i & (R - 1), c8 = i / R;
        const float z = zeta ? __builtin_amdgcn_exp2f(lg * (float)(R - 1 - r)) : 1.0f;
#pragma unroll
        for (int j = 0; j < 4; ++j) { const unsigned w = v[k][j]; float lo = bf2f(w & 0xffffu), hi = bf2f(w >> 16);
            if (zeta) { lo *= z; hi *= z; dst[(c8 * 8 + 2 * j) * LS + r] = (bfu)f2bf(lo); dst[(c8 * 8 + 2 * j + 1) * LS + r] = (bfu)f2bf(hi); }
            else { dst[(c8 * 8 + 2 * j) * LS + r] = (bfu)(w & 0xffffu); dst[(c8 * 8 + 2 * j + 1) * LS + r] = (bfu)(w >> 16); } } }
}
template <int NIT> DI void stage_rows(LAS bfu* dst, int LS, const bfu* src, size_t gp, int C8, int tid) { u32x4 v[NIT]; rows_load<NIT>(v, src, gp, C8, tid); rows_store<NIT>(dst, LS, v, C8, tid); }
template <int NIT> DI void stage_T(LAS bfu* dst, int LS, const bfu* src, size_t gp, int R, int tid, bool zeta, float lg) { u32x4 v[NIT]; T_load<NIT>(v, src, gp, R, tid); T_store<NIT>(dst, LS, v, R, tid, zeta, lg); }
DI void rt_state_phase(LAS unsigned char* lds, int bx, int G, const bfu* Kb, const bfu* Vb, bfu* SR, int tid) {
    asm volatile("" : "+v"(tid));
    const int w = tid >> 6, lane = tid & 63, fr = lane & 15, fq = lane >> 4;
    LAS bfu* sKT = (LAS bfu*)lds; LAS bfu* sVT = (LAS bfu*)(lds + 69632);
    int unit = bx; if (unit >= 512) return;
    u32x4 pk[8], pv[4];
    T_load<8>(pk, Kb + (size_t)(128 * (unit >> 2)) * 1024 + 256 * (unit & 3), 1024, 128, tid);
    T_load<4>(pv, Vb + (size_t)(128 * (unit >> 2)) * 2048 + 512 * (unit & 3), 2048, 128, tid);
    for (; unit < 512; unit += G) {
        const int c = unit >> 2, h = unit & 3; const float lg = __log2f(1.0f - exp2f(-5.0f - (float)h));
        T_store<8>(sKT, 136, pk, 128, tid, true, lg);
        for (int dvs = 0; dvs < 4; ++dvs) {
            T_store<4>(sVT, 136, pv, 128, tid, false, 0.f);
            if (dvs < 3) T_load<4>(pv, Vb + (size_t)(128 * c) * 2048 + 512 * h + 128 * (dvs + 1), 2048, 128, tid);
            else if (unit + G < 512) { const int nu = unit + G; T_load<4>(pv, Vb + (size_t)(128 * (nu >> 2)) * 2048 + 512 * (nu & 3), 2048, 128, tid); T_load<8>(pk, Kb + (size_t)(128 * (nu >> 2)) * 1024 + 256 * (nu & 3), 1024, 128, tid); }
            LDS_BARRIER();
            f32x4 acc[2][8];
#pragma unroll
            for (int mi = 0; mi < 2; ++mi)
#pragma unroll
                for (int ni = 0; ni < 8; ++ni) acc[mi][ni] = (f32x4){0.f, 0.f, 0.f, 0.f};
            wave_mma<2, 8>(acc, sKT + (32 * w) * 136, 136, sVT, 136, 128, fr, fq);
            bfu* dst = SR + (size_t)unit * 131072;
#pragma unroll
            for (int mi = 0; mi < 2; ++mi)
#pragma unroll
                for (int ni = 0; ni < 8; ++ni) { u32x2 o; o.x = pk2(acc[mi][ni][0], acc[mi][ni][1]); o.y = pk2(acc[mi][ni][2], acc[mi][ni][3]);
                    *(u32x2*)(dst + (size_t)(128 * dvs + 16 * ni + fr) * 256 + 32 * w + 16 * mi + 4 * fq) = o; }
            LDS_BARRIER();
        }
    }
}
DI void rt_scan(bfu* SR, int gtid, int gthreads) {
    asm volatile("" : "+v"(gtid));
    for (int e4 = gtid; e4 < 131072; e4 += gthreads) {
        const int h = e4 >> 15; const size_t idx = (size_t)(e4 & 32767) * 4;
        const float g = exp2f(128.0f * __log2f(1.0f - exp2f(-5.0f - (float)h)));
        float r0 = 0.f, r1 = 0.f, r2 = 0.f, r3 = 0.f;
        for (int cb = 0; cb < 128; cb += 16) {
            u32x2 v[16];
#pragma unroll
            for (int k = 0; k < 16; ++k) v[k] = *(const u32x2*)(SR + (size_t)((cb + k) * 4 + h) * 131072 + idx);
#pragma unroll
            for (int k = 0; k < 16; ++k) { u32x2 o; o.x = pk2(r0, r1); o.y = pk2(r2, r3); *(u32x2*)(SR + (size_t)((cb + k) * 4 + h) * 131072 + idx) = o;
                r0 = g * r0 + bf2f(v[k].x & 0xffffu); r1 = g * r1 + bf2f(v[k].x >> 16); r2 = g * r2 + bf2f(v[k].y & 0xffffu); r3 = g * r3 + bf2f(v[k].y >> 16); }
        }
    }
}
DI void rt_chunk_unit(LAS unsigned char* lds, int unit, const bfu* Qb, const bfu* Kb, const bfu* Vb, bfu* Ob, const bfu* Gb, const bfu* SR, int tid) {
    asm volatile("" : "+v"(tid));
    const int c = unit >> 2, h = unit & 3, w = tid >> 6, lane = tid & 63, fr = lane & 15, fq = lane >> 4;
    const float lg = __log2f(1.0f - exp2f(-5.0f - (float)h));
    LAS bfu* sQ = (LAS bfu*)lds; LAS bfu* sK = (LAS bfu*)(lds + 67584); LAS bfu* sAtt = sK; LAS bfu* sVT = (LAS bfu*)(lds + 102400); LAS bfu* sR = (LAS bfu*)(lds + 119808);
    stage_rows<8>(sQ, 264, Qb + (size_t)(128 * c) * 1024 + 256 * h, 1024, 32, tid);
    stage_rows<8>(sK, 264, Kb + (size_t)(128 * c) * 1024 + 256 * h, 1024, 32, tid);
    __syncthreads();
    { f32x4 a[1][8];
#pragma unroll
      for (int ni = 0; ni < 8; ++ni) a[0][ni] = (f32x4){0.f, 0.f, 0.f, 0.f};
      wave_mma<1, 8>(a, sQ + (16 * w) * 264, 264, sK, 264, 256, fr, fq);
      __syncthreads();
#pragma unroll
      for (int ni = 0; ni < 8; ++ni)
#pragma unroll
          for (int j = 0; j < 4; ++j) { const int t = 16 * w + 4 * fq + j, s = 16 * ni + fr; const float v = (t >= s) ? a[0][ni][j] * __builtin_amdgcn_exp2f(lg * (float)(t - s)) : 0.f; sAtt[t * 136 + s] = (bfu)f2bf(v); }
    }
    float ss[4] = {0.f, 0.f, 0.f, 0.f}, xi[4];
#pragma unroll
    for (int j = 0; j < 4; ++j) xi[j] = __builtin_amdgcn_exp2f(lg * (float)(16 * w + 4 * fq + j + 1));
    u32x4 pv[2], pr[4];
    T_load<2>(pv, Vb + (size_t)(128 * c) * 2048 + 512 * h, 2048, 128, tid);
    rows_load<4>(pr, SR + (size_t)unit * 131072, 256, 32, tid);
    for (int sl = 0; sl < 8; ++sl) {
        T_store<2>(sVT, 136, pv, 128, tid, false, 0.f);
        rows_store<4>(sR, 264, pr, 32, tid);
        if (sl < 7) { T_load<2>(pv, Vb + (size_t)(128 * c) * 2048 + 512 * h + 64 * (sl + 1), 2048, 128, tid); rows_load<4>(pr, SR + (size_t)unit * 131072 + (size_t)(64 * (sl + 1)) * 256, 256, 32, tid); }
        LDS_BARRIER();
        f32x4 o[1][4];
#pragma unroll
        for (int ni = 0; ni < 4; ++ni) o[0][ni] = (f32x4){0.f, 0.f, 0.f, 0.f};
        wave_mma<1, 4>(o, sQ + (16 * w) * 264, 264, sR, 264, 256, fr, fq);
#pragma unroll
        for (int ni = 0; ni < 4; ++ni)
#pragma unroll
            for (int j = 0; j < 4; ++j) o[0][ni][j] *= xi[j];
        wave_mma<1, 4>(o, sAtt + (16 * w) * 136, 136, sVT, 136, 128, fr, fq);
#pragma unroll
        for (int ni = 0; ni < 4; ++ni)
#pragma unroll
            for (int j = 0; j < 4; ++j) { const float v = o[0][ni][j]; ss[j] += v * v; Ob[(size_t)(128 * c + 16 * w + 4 * fq + j) * 2048 + 512 * h + 64 * sl + 16 * ni + fr] = (bfu)f2bf(v); }
        LDS_BARRIER();
    }
    LAS float* sSS = (LAS float*)(lds + 67584);
#pragma unroll
    for (int j = 0; j < 4; ++j) { float s = ss[j]; s += __shfl_xor(s, 1); s += __shfl_xor(s, 2); s += __shfl_xor(s, 4); s += __shfl_xor(s, 8);
        if (fr == 0) sSS[16 * w + 4 * fq + j] = __builtin_amdgcn_rsqf(s * (1.0f / 512.0f) + EPS); }
    __syncthreads();
#pragma unroll
    for (int hb = 0; hb < 2; ++hb) { u32x4 ov[8], gv[8];
#pragma unroll
        for (int k = 0; k < 8; ++k) { const int i = tid + 512 * (8 * hb + k), t = i >> 6, c8 = i & 63; const size_t off = (size_t)(128 * c + t) * 2048 + 512 * h + 8 * c8; ov[k] = *(const u32x4*)(Ob + off); gv[k] = *(const u32x4*)(Gb + off); }
#pragma unroll
        for (int k = 0; k < 8; ++k) { const int i = tid + 512 * (8 * hb + k), t = i >> 6, c8 = i & 63; const size_t off = (size_t)(128 * c + t) * 2048 + 512 * h + 8 * c8; const float rstd = sSS[t]; u32x4 r;
#pragma unroll
            for (int j = 0; j < 4; ++j) r[j] = pk2(bf2f(ov[k][j] & 0xffffu) * rstd * bf2f(gv[k][j] & 0xffffu), bf2f(ov[k][j] >> 16) * rstd * bf2f(gv[k][j] >> 16));
            *(u32x4*)(Ob + off) = r; } }
    __syncthreads();
}
DI void rt_gate(bfu* Vb, const bfu* Gb, const float* RTSS, int gtid, int gthreads) {
    asm volatile("" : "+v"(gtid));
    for (int i = gtid; i < T * 256; i += gthreads) { const int t = i >> 8, col = (i & 255) * 8, h = col >> 9;
        const float rstd = __builtin_amdgcn_rsqf(RTSS[t * 4 + h] * (1.0f / 512.0f) + EPS);
        const u32x4 o = *(const u32x4*)(Vb + (size_t)t * 2048 + col), g = *(const u32x4*)(Gb + (size_t)t * 2048 + col); u32x4 r;
#pragma unroll
        for (int j = 0; j < 4; ++j) r[j] = pk2(bf2f(o[j] & 0xffffu) * rstd * bf2f(g[j] & 0xffffu), bf2f(o[j] >> 16) * rstd * bf2f(g[j] >> 16));
        *(u32x4*)(Vb + (size_t)t * 2048 + col) = r; }
}
DI void sg_unit(LAS unsigned char* lds, int unit, const bfu* Ub, bfu* Uo, const bfu* Vb, const float* SGSTAT, const float* w_s, const float* b_s, const float* v_gain, int tid) {
    asm volatile("" : "+v"(tid));
    const int n = unit >> 3, g = unit & 7, w = tid >> 6, lane = tid & 63, fr = lane & 15, fq = lane >> 4;
    LAS bfu* sW = (LAS bfu*)lds; LAS bfu* sVT = (LAS bfu*)(lds + 34816); LAS float* sRstd = (LAS float*)(lds + 139264); LAS bfu* sM = sVT;
    if (tid < 128) { const f32x4* p = (const f32x4*)(SGSTAT + (size_t)(128 * n + tid) * 48); float s = 0.f;
#pragma unroll
        for (int k = 0; k < 12; ++k) { const f32x4 v = p[k]; s += (v[0] + v[1]) + (v[2] + v[3]); }
        sRstd[tid] = __builtin_amdgcn_rsqf(s * (1.0f / 3072.0f) + EPS); }
    stage_T<12>(sVT, 136, Vb + (size_t)(128 * n) * 3072 + 384 * g, 3072, 128, tid, false, 0.f);
    { f32x4 wv[8];
#pragma unroll
      for (int k = 0; k < 8; ++k) wv[k] = *(const f32x4*)(w_s + (size_t)g * 16384 + 4 * (tid + 512 * k));
      __syncthreads();
#pragma unroll
      for (int k = 0; k < 8; ++k) { const int i = 4 * (tid + 512 * k), t = i >> 7, s = i & 127; u32x2 o;
          const float a0 = (s <= t) ? wv[k][0] * sRstd[s] : 0.f, a1 = (s + 1 <= t) ? wv[k][1] * sRstd[s + 1] : 0.f, a2 = (s + 2 <= t) ? wv[k][2] * sRstd[s + 2] : 0.f, a3 = (s + 3 <= t) ? wv[k][3] * sRstd[s + 3] : 0.f;
          o.x = pk2(a0, a1); o.y = pk2(a2, a3); *(LAS u32x2*)(sW + t * 136 + s) = o; } }
    __syncthreads();
    u32x4 uv[12];
#pragma unroll
    for (int k = 0; k < 12; ++k) { const int i = tid + 512 * k, t = i / 48, c8 = i - t * 48; uv[k] = *(const u32x4*)(Ub + (size_t)(128 * n + t) * 3072 + 384 * g + 8 * c8); }
    f32x4 acc[1][24];
#pragma unroll
    for (int ni = 0; ni < 24; ++ni) acc[0][ni] = (f32x4){0.f, 0.f, 0.f, 0.f};
    wave_mma<1, 24>(acc, sW + (16 * w) * 136, 136, sVT, 136, 128, fr, fq);
    float bs[4];
#pragma unroll
    for (int j = 0; j < 4; ++j) bs[j] = b_s[g * 128 + 16 * w + 4 * fq + j];
    LDS_BARRIER();
#pragma unroll
    for (int ni = 0; ni < 24; ++ni) { const int cl = 16 * ni + fr; const float gn = v_gain[384 * g + cl];
#pragma unroll
        for (int j = 0; j < 4; ++j) sM[(16 * w + 4 * fq + j) * 392 + cl] = (bfu)f2bf(acc[0][ni][j] * gn + bs[j]); }
    LDS_BARRIER();
    {
#pragma unroll
      for (int k = 0; k < 12; ++k) { const int i = tid + 512 * k, t = i / 48, c8 = i - t * 48; const u32x4 mv = *(const LAS u32x4*)(sM + t * 392 + 8 * c8); u32x4 o;
#pragma unroll
          for (int j = 0; j < 4; ++j) o[j] = pk2(bf2f(uv[k][j] & 0xffffu) * bf2f(mv[j] & 0xffffu), bf2f(uv[k][j] >> 16) * bf2f(mv[j] >> 16));
          *(u32x4*)(Uo + (size_t)(128 * n + t) * 3072 + 384 * g + 8 * c8) = o; } }
    LDS_BARRIER();
}
template <int PASS> DI void lr_unit(LAS unsigned char* lds, int unit, const bfu* __restrict__ P, const bfu* __restrict__ WAX, const float* __restrict__ conv_w, const float* __restrict__ conv_b,
                                    const float* __restrict__ b_a, const float* __restrict__ b_x, const float* __restrict__ lam, float* AGG, bfu* __restrict__ A2, bfu* __restrict__ XBUF, bfu* __restrict__ BBUF, int tid) {
    asm volatile("" : "+v"(tid));
    const int tile = unit / 12, n = unit - tile * 12, ch0 = 128 * n, w = tid >> 6, lane = tid & 63, fr = lane & 15, fq = lane >> 4;
    LAS bfu* sB = (LAS bfu*)lds; LAS bfu* sA = (LAS bfu*)(lds + 69632); LAS float* sa = (LAS float*)(lds + 87040); LAS float* sb = (LAS float*)(lds + 120064);
    LAS float* sAgg = (LAS float*)(lds + 153088); LAS float* sAgg2 = (LAS float*)(lds + 157184);
    const int ch = tid & 127, seg = tid >> 7;
    stage_rows<8>(sB, 136, WAX + (size_t)n * 32768, 128, 16, tid);
    const float cw0 = conv_w[ch0 + ch], cw1 = conv_w[1536 + ch0 + ch], cw2 = conv_w[3072 + ch0 + ch], cw3 = conv_w[4608 + ch0 + ch], cb = conv_b[ch0 + ch];
    float spv[4], bav[4], bxv[4];
#pragma unroll
    for (int ni = 0; ni < 4; ++ni) { const int c2 = 64 * (w >> 2) + 16 * ni + fr; spv[ni] = -8.0f * LOG2E * log1pf(__expf(-lam[ch0 + c2])); bav[ni] = b_a[ch0 + c2]; bxv[ni] = b_x[ch0 + c2]; }
    float carryP = 1.f, carryH = 0.f;
    if (PASS == 2) { const int lo = (tile * seg) >> 2, hi = (tile * (seg + 1)) >> 2; float Pq = 1.f, Hq = 0.f;
        for (int k = lo; k < hi; ++k) { const float2 ag = *(const float2*)(AGG + ((size_t)k * 1536 + ch0 + ch) * 2); Hq = ag.x * Hq + ag.y; Pq *= ag.x; }
        sAgg2[(seg * 128 + ch) * 2] = Pq; sAgg2[(seg * 128 + ch) * 2 + 1] = Hq;
        __syncthreads();
#pragma unroll
        for (int s = 0; s < 4; ++s) carryH = sAgg2[(s * 128 + ch) * 2] * carryH + sAgg2[(s * 128 + ch) * 2 + 1]; }
    bfu xr[19], gr[16];
#define LR_LOADS(sb) do { const int tb_ = 256 * tile + 64 * (sb) + 16 * seg; \
        _Pragma("unroll") for (int k = 0; k < 19; ++k) { const int tt = tb_ - 3 + k; xr[k] = (tt >= 0) ? P[(size_t)tt * 3072 + 1536 + ch0 + ch] : (bfu)0; } \
        if (PASS == 2) { _Pragma("unroll") for (int k = 0; k < 16; ++k) gr[k] = P[(size_t)(tb_ + k) * 3072 + ch0 + ch]; } } while (0)
    LR_LOADS(0);
    for (int sub = 0; sub < 4; ++sub) {
        const int t0 = 256 * tile + 64 * sub, tb = t0 + 16 * seg;
        { float xv[19];
#pragma unroll
          for (int k = 0; k < 19; ++k) xv[k] = bf2f(xr[k]);
#pragma unroll
          for (int k = 0; k < 16; ++k) { const float xc = cb + cw0 * xv[k] + cw1 * xv[k + 1] + cw2 * xv[k + 2] + cw3 * xv[k + 3]; sA[(16 * seg + k) * 136 + ch] = (bfu)f2bf(xc); } }
        float gt[16];
        if (PASS == 2) {
#pragma unroll
            for (int k = 0; k < 16; ++k) gt[k] = bf2f(gr[k]); }
        if (sub < 3) LR_LOADS(sub + 1);
        LDS_BARRIER();
        { const int wrow = w & 3, half = w >> 2;
          f32x4 ar[1][4], ai[1][4];
#pragma unroll
          for (int ni = 0; ni < 4; ++ni) { ar[0][ni] = (f32x4){0.f, 0.f, 0.f, 0.f}; ai[0][ni] = (f32x4){0.f, 0.f, 0.f, 0.f}; }
          wave_mma<1, 4>(ar, sA + (16 * wrow) * 136, 136, sB + (64 * half) * 136, 136, 128, fr, fq);
          wave_mma<1, 4>(ai, sA + (16 * wrow) * 136, 136, sB + (128 + 64 * half) * 136, 136, 128, fr, fq);
#pragma unroll
          for (int ni = 0; ni < 4; ++ni) { const int c2 = 64 * half + 16 * ni + fr;
#pragma unroll
              for (int j = 0; j < 4; ++j) { const int t = 16 * wrow + 4 * fq + j; const float r = sigmoidf_(ar[0][ni][j] + bav[ni]), ig = sigmoidf_(ai[0][ni][j] + bxv[ni]);
                  const float xl = r * spv[ni], a = __builtin_amdgcn_exp2f(xl), bb = __builtin_amdgcn_sqrtf(fmaxf(1.0f - a * a, 1e-12f)) * (ig * bf2f(sA[t * 136 + c2]));
                  sa[t * 129 + c2] = xl; sb[t * 129 + c2] = bb; } } }
        LDS_BARRIER();
        { float Pp = 1.f, H = 0.f;
#pragma unroll
          for (int k = 0; k < 16; ++k) { const float xl = sa[(16 * seg + k) * 129 + ch], bbv = sb[(16 * seg + k) * 129 + ch], a = __builtin_amdgcn_exp2f(xl); H = a * H + bbv; Pp *= a;
              if (PASS == 1) { XBUF[(size_t)(tb + k) * 1536 + ch0 + ch] = (bfu)f2bf(xl); BBUF[(size_t)(tb + k) * 1536 + ch0 + ch] = (bfu)f2bf(bbv); } }
          sAgg[(seg * 128 + ch) * 2] = Pp; sAgg[(seg * 128 + ch) * 2 + 1] = H; }
        LDS_BARRIER();
        if (PASS == 1) {
#pragma unroll
            for (int s = 0; s < 4; ++s) { const float p = sAgg[(s * 128 + ch) * 2], hh = sAgg[(s * 128 + ch) * 2 + 1]; carryH = p * carryH + hh; carryP *= p; }
        } else {
            float h = carryH;
            for (int s = 0; s < seg; ++s) h = sAgg[(s * 128 + ch) * 2] * h + sAgg[(s * 128 + ch) * 2 + 1];
#pragma unroll
            for (int k = 0; k < 16; ++k) { h = __builtin_amdgcn_exp2f(sa[(16 * seg + k) * 129 + ch]) * h + sb[(16 * seg + k) * 129 + ch]; A2[(size_t)(tb + k) * 1536 + ch0 + ch] = (bfu)f2bf(h * gelu_tanh(gt[k])); }
#pragma unroll
            for (int s = 0; s < 4; ++s) carryH = sAgg[(s * 128 + ch) * 2] * carryH + sAgg[(s * 128 + ch) * 2 + 1];
        }
        LDS_BARRIER();
    }
#undef LR_LOADS
    if (PASS == 1 && seg == 0) *(float2*)(AGG + ((size_t)tile * 1536 + ch0 + ch) * 2) = make_float2(carryP, carryH);
}
DI void lr_stream_unit(LAS unsigned char* lds, int unit, const bfu* __restrict__ P, const bfu* __restrict__ XBUF, const bfu* __restrict__ BBUF, const float* __restrict__ AGG, bfu* __restrict__ A2, int tid) {
    asm volatile("" : "+v"(tid));
    const int tile = unit / 12, n = unit - tile * 12, ch0 = 128 * n, ch = tid & 127, seg = tid >> 7, tb = 256 * tile + 64 * seg;
    LAS float* sAgg = (LAS float*)lds; LAS float* sAgg2 = (LAS float*)(lds + 4096);
    const unsigned base = (unsigned)tb * 1536u + (unsigned)(ch0 + ch), gbase = (unsigned)tb * 3072u + (unsigned)(ch0 + ch);
    float Pp = 1.f, H = 0.f;
    for (int hb = 0; hb < 4; ++hb) { bfu xr[16], br[16];
#pragma unroll
        for (int k = 0; k < 16; ++k) { xr[k] = XBUF[base + (unsigned)(16 * hb + k) * 1536u]; br[k] = BBUF[base + (unsigned)(16 * hb + k) * 1536u]; }
#pragma unroll
        for (int k = 0; k < 16; ++k) { const float a = __builtin_amdgcn_exp2f(bf2f(xr[k])); H = a * H + bf2f(br[k]); Pp *= a; } }
    sAgg[(seg * 128 + ch) * 2] = Pp; sAgg[(seg * 128 + ch) * 2 + 1] = H;
    { const int lo = (tile * seg) >> 2, hi = (tile * (seg + 1)) >> 2; float Pq = 1.f, Hq = 0.f;
      int k = lo;
      for (; k + 4 <= hi; k += 4) { float2 ag[4];
#pragma unroll
          for (int q = 0; q < 4; ++q) ag[q] = *(const float2*)(AGG + ((size_t)(k + q) * 1536 + ch0 + ch) * 2);
#pragma unroll
          for (int q = 0; q < 4; ++q) { Hq = ag[q].x * Hq + ag[q].y; Pq *= ag[q].x; } }
      for (; k < hi; ++k) { const float2 ag = *(const float2*)(AGG + ((size_t)k * 1536 + ch0 + ch) * 2); Hq = ag.x * Hq + ag.y; Pq *= ag.x; }
      sAgg2[(seg * 128 + ch) * 2] = Pq; sAgg2[(seg * 128 + ch) * 2 + 1] = Hq; }
    LDS_BARRIER();
    float h = 0.f;
#pragma unroll
    for (int s = 0; s < 4; ++s) h = sAgg2[(s * 128 + ch) * 2] * h + sAgg2[(s * 128 + ch) * 2 + 1];
    for (int s = 0; s < seg; ++s) h = sAgg[(s * 128 + ch) * 2] * h + sAgg[(s * 128 + ch) * 2 + 1];
    for (int hb = 0; hb < 4; ++hb) { bfu xr[16], br[16], gr[16];
#pragma unroll
        for (int k = 0; k < 16; ++k) { xr[k] = XBUF[base + (unsigned)(16 * hb + k) * 1536u]; br[k] = BBUF[base + (unsigned)(16 * hb + k) * 1536u]; gr[k] = P[gbase + (unsigned)(16 * hb + k) * 3072u]; }
#pragma unroll
        for (int k = 0; k < 16; ++k) { h = __builtin_amdgcn_exp2f(bf2f(xr[k])) * h + bf2f(br[k]); A2[base + (unsigned)(16 * hb + k) * 1536u] = (bfu)f2bf(h * gelu_tanh(bf2f(gr[k]))); } }
    LDS_BARRIER();
}
DI void da_combine(bfu* O0, const bfu* O1, const float* lamp, int gwave, int nwaves, int lane) {
    asm volatile("" : "+v"(lane));
    const float s01 = wave_sum(lamp[lane] * lamp[64 + lane]), s23 = wave_sum(lamp[128 + lane] * lamp[192 + lane]);
    const float lmb = __expf(s01) - __expf(s23) + 0.2f;
    for (int grp0 = gwave * 4 + (lane >> 4); grp0 < T * 8; grp0 += nwaves * 8) {
        size_t base[2]; u32x4 a[2], bq[2]; bool ok[2];
#pragma unroll
        for (int q = 0; q < 2; ++q) { const int grp = grp0 + q * nwaves * 4; ok[q] = grp < T * 8; const int gg = ok[q] ? grp : grp0; base[q] = (size_t)(gg >> 3) * 1024 + (gg & 7) * 128 + (lane & 15) * 8; a[q] = *(const u32x4*)(O0 + base[q]); bq[q] = *(const u32x4*)(O1 + base[q]); }
#pragma unroll
        for (int q = 0; q < 2; ++q) { float o[8], ss = 0.f;
#pragma unroll
            for (int j = 0; j < 4; ++j) { o[2 * j] = bf2f(a[q][j] & 0xffffu) - lmb * bf2f(bq[q][j] & 0xffffu); o[2 * j + 1] = bf2f(a[q][j] >> 16) - lmb * bf2f(bq[q][j] >> 16); ss += o[2 * j] * o[2 * j] + o[2 * j + 1] * o[2 * j + 1]; }
            ss += __shfl_xor(ss, 1); ss += __shfl_xor(ss, 2); ss += __shfl_xor(ss, 4); ss += __shfl_xor(ss, 8);
            const float rstd = __builtin_amdgcn_rsqf(ss * (1.0f / 128.0f) + EPS); u32x4 r;
#pragma unroll
            for (int j = 0; j < 4; ++j) r[j] = pk2(o[2 * j] * rstd, o[2 * j + 1] * rstd);
            if (ok[q]) *(u32x4*)(O0 + base[q]) = r; } }
}
struct Args { const float* in[31]; float* out; unsigned char* ws; };
#define GAS __attribute__((address_space(1)))
DI unsigned char* opq(unsigned char* p) { GAS unsigned char* g = (GAS unsigned char*)p; asm volatile("" : "+s"(g)); return (unsigned char*)g; }
#define TID_O() ({ int t_ = threadIdx.x; asm volatile("" : "+v"(t_)); t_; })
DI const float* inp(const Args& a, int i) { asm volatile("" : "+s"(i)); const GAS float* g = (const GAS float*)a.in[i]; asm volatile("" : "+s"(g)); return (const float*)g; }
#define STAT ((float*)(opq(ws) + WS_STAT))
#define SGSTAT ((float*)(opq(ws) + WS_SGSTAT))
#define RTSS ((float*)(opq(ws) + WS_RTSS))
#define LRAGG ((float*)(opq(ws) + WS_LRAGG))
#define XB ((bfu*)(opq(ws) + WS_XB))
#define W1IN ((bfu*)(opq(ws) + WS_W1IN))
#define W1OUT ((bfu*)(opq(ws) + WS_W1OUT))
#define W2IN ((bfu*)(opq(ws) + WS_W2IN))
#define W2OUT ((bfu*)(opq(ws) + WS_W2OUT))
#define WMIN ((bfu*)(opq(ws) + WS_WMIN))
#define WMOUT ((bfu*)(opq(ws) + WS_WMOUT))
#define WAX ((bfu*)(opq(ws) + WS_WAX))
#define ACT ((bfu*)(opq(ws) + WS_ACT))
#define SR ((bfu*)(opq(ws) + WS_SR))
DI void convert_weights(const Args& args, unsigned char* ws, int groups, int l, int widx, int nw, LAS float* scr, int lane_o) {
    constexpr int I_FIN = (D / 64) * (2 * FF / 32), I_FOUT = (FF / 64) * (D / 32);
    const float* wmi; const float* wmo; int NMI, KMO, MAPI = 0, gmask = 0x7fffffff; const float* gmo = nullptr; float gsc = 1.0f;
    if (l == 0) { wmi = inp(args, 8); wmo = inp(args, 13); NMI = 3072; KMO = 1024; MAPI = 2; gmo = inp(args, 12); gmask = 127; gsc = 0.8f; }
    else if (l == 1) { wmi = inp(args, 14); wmo = inp(args, 16); NMI = 6144; KMO = 2048; gmo = inp(args, 15); }
    else if (l == 2) { wmi = inp(args, 17); wmo = inp(args, 21); NMI = 6144; KMO = 3072; }
    else { wmi = inp(args, 22); wmo = inp(args, 30); NMI = 3072; KMO = 1536; }
    const int nAi = (groups & 1) ? I_FIN : 0, nAo = (groups & 1) ? I_FOUT : 0, nCi = (groups & 4) ? I_FIN : 0, nCo = (groups & 4) ? I_FOUT : 0;
    const int I_MI = (groups & 2) ? (D / 64) * (NMI / 32) : 0, I_MO = (groups & 2) ? (KMO / 64) * (D / 32) : 0, I_AX = ((groups & 2) && l == 3) ? 192 : 0;
    const int NIT = nAi + nAo + nCi + nCo + I_MI + I_MO + I_AX;
    for (int it = widx; it < NIT; it += nw) { CvItem cur; f32x4 cv[8]; float cg[8]; int r = it;
        do {
            if (r < nAi) { cv_make(cur, r, inp(args, 2) + (size_t)l * D * 2 * FF, D, 2 * FF, W1IN, 1, inp(args, 1) + l * D, 0x7fffffff, 1.0f); break; } r -= nAi;
            if (r < nCi) { cv_make(cur, r, inp(args, 6) + (size_t)l * D * 2 * FF, D, 2 * FF, W2IN, 1, inp(args, 5) + l * D, 0x7fffffff, 1.0f); break; } r -= nCi;
            if (r < nAo) { cv_make(cur, r, inp(args, 3) + (size_t)l * FF * D, FF, D, W1OUT, 0, nullptr, 0, 1.0f); break; } r -= nAo;
            if (r < nCo) { cv_make(cur, r, inp(args, 7) + (size_t)l * FF * D, FF, D, W2OUT, 0, nullptr, 0, 1.0f); break; } r -= nCo;
            if (r < I_MI) { cv_make(cur, r, wmi, D, NMI, WMIN, MAPI, inp(args, 4) + l * D, 0x7fffffff, 1.0f); break; } r -= I_MI;
            if (r < I_MO) { cv_make(cur, r, wmo, KMO, D, WMOUT, 0, gmo, gmask, gsc); break; } r -= I_MO;
            { const int nwx = r >> 3, itx = r & 7, n = nwx >> 1, which = nwx & 1;
              cv_make(cur, itx, (which ? inp(args, 27) : inp(args, 25)) + (size_t)n * 16384, 128, 128, WAX + (size_t)n * 32768 + which * 16384, 0, nullptr, 0, 1.0f); }
        } while (0);
        cv_load(cur, cv, cg, lane_o); cv_store(cur, cv, cg, scr, lane_o); }
}
#define XB_TMO      128
#define XB_XCNT(j)  (256  + 64 * (j))
#define XB_XSUB(j)  (1280 + 64 * (j))
#define XB_XGEN(j)  (2304 + 64 * (j))
#define XB_TOP      3328
#define XB_TOPGEN   3392
#define XCD_BAR_WORDS 3456
#define XB_SPIN_CAP (1u << 18)

__device__ __forceinline__ unsigned xb_ld(unsigned* p)              { return __hip_atomic_load(p, __ATOMIC_RELAXED, __HIP_MEMORY_SCOPE_AGENT); }
__device__ __forceinline__ unsigned xb_add(unsigned* p, unsigned v) { return __hip_atomic_fetch_add(p, v, __ATOMIC_RELAXED, __HIP_MEMORY_SCOPE_AGENT); }
__device__ __forceinline__ unsigned xb_xcc_id() { return (unsigned)__builtin_amdgcn_s_getreg((3 << 11) | 20) & 0xFu; }
#define XB_SPIN(cond, bar) do { unsigned _sp = 0; while (cond) { __builtin_amdgcn_s_sleep(1); \
    if ((++_sp & 255u) == 0u) { if (xb_ld(&(bar)[XB_TMO])) break; if (_sp > XB_SPIN_CAP) { atomicAdd(&(bar)[XB_TMO], 1u); break; } } } } while (0)

struct XcdBarrier {
    unsigned* bar; unsigned x;
    volatile LAS unsigned* st;
};

__device__ __forceinline__ XcdBarrier xcd_barrier_post(unsigned* bar, volatile LAS unsigned* st) {
    XcdBarrier b; b.bar = bar; b.x = xb_xcc_id(); b.st = st;
    if (threadIdx.x == 0) (void)xb_add(&bar[XB_XCNT(b.x)], 1u);
    return b;
}
__device__ __forceinline__ void xcd_barrier_complete(unsigned* bar, unsigned x, unsigned& nloc, unsigned& nx) {
    const unsigned G = gridDim.x * gridDim.y * gridDim.z;
    unsigned sum, cnt, mine, sp = 0u;
    for (;;) {
        sum = 0u; cnt = 0u; mine = 0u;
#pragma unroll
        for (unsigned j = 0; j < 16; ++j) { const unsigned c = xb_ld(&bar[XB_XCNT(j)]); sum += c; cnt += (c > 0u) ? 1u : 0u; mine = (j == x) ? c : mine; }
        if (sum == G) break;
        __builtin_amdgcn_s_sleep(1);
        if ((++sp & 255u) == 0u) { if (xb_ld(&bar[XB_TMO])) break; if (sp > XB_SPIN_CAP) { atomicAdd(&bar[XB_TMO], 1u); break; } }
    }
    nloc = mine > 0u ? mine : 1u; nx = cnt > 0u ? cnt : 1u;
}

__device__ __forceinline__ void xcd_barrier(const XcdBarrier& b) {
    asm volatile("s_waitcnt vmcnt(0)" ::: "memory");
    __syncthreads();
    if (threadIdx.x == 0) {
        unsigned* bar = b.bar;
        __builtin_amdgcn_s_waitcnt(0);
        unsigned nloc = b.st[0], nx = b.st[1];
        if (nloc == 0u) { xcd_barrier_complete(bar, b.x, nloc, nx); b.st[0] = nloc; b.st[1] = nx; }
        const unsigned old = xb_add(&bar[XB_XSUB(b.x)], 1u);
        const unsigned gen = old / nloc;
        if (old + 1u == (gen + 1u) * nloc) {
            __builtin_amdgcn_fence(__ATOMIC_RELEASE, "agent");
            asm volatile("s_waitcnt vmcnt(0)" ::: "memory");
            const unsigned og = xb_add(&bar[XB_TOP], 1u);
            const unsigned tg = og / nx;
            if (og + 1u == (tg + 1u) * nx) xb_add(&bar[XB_TOPGEN], 1u);
            else XB_SPIN(xb_ld(&bar[XB_TOPGEN]) == tg, bar);
            __builtin_amdgcn_fence(__ATOMIC_ACQUIRE, "agent");
            xb_add(&bar[XB_XGEN(b.x)], 1u);
            asm volatile("s_waitcnt vmcnt(0)" ::: "memory");
        } else {
            XB_SPIN(xb_ld(&bar[XB_XGEN(b.x)]) == gen, bar);
            __builtin_amdgcn_fence(__ATOMIC_ACQUIRE, "agent");
            asm volatile("s_waitcnt vmcnt(0)" ::: "memory");
        }
    }
    __syncthreads();
}

#ifndef REP_ATT
#define REP_ATT 1
#endif
#ifndef REP_FFO
#define REP_FFO 1
#endif
#ifndef REP_RTC
#define REP_RTC 1
#endif
#ifndef REP_SG
#define REP_SG 1
#endif
#ifndef GEMM_ALIGN
#define GEMM_ALIGN true
#endif
#ifndef GEMM_SP2
#define GEMM_SP2 true
#endif
#ifndef REP_CV
#define REP_CV 1
#endif
#ifndef REP_LR
#define REP_LR 1
#endif
#ifndef REP_RTS
#define REP_RTS 1
#endif
#ifndef REP_FFI
#define REP_FFI 1
#endif
__global__ void __launch_bounds__(512, 2) mk_fwd(Args args) {
    extern __shared__ __attribute__((aligned(16))) unsigned char lds_raw[];
    cg::grid_group grid = cg::this_grid();
    LAS unsigned char* lds = (LAS unsigned char*)lds_raw;
    const int G = gridDim.x, bx = blockIdx.x;
    volatile LAS unsigned* bst = (volatile LAS unsigned*)(lds + 163824);
    if (threadIdx.x < 2) bst[threadIdx.x] = 0u;
    if (bx == 0) for (int i = threadIdx.x; i < XCD_BAR_WORDS; i += 512) ((unsigned*)(args.ws + WS_CTL + 4096))[i] = 0u;
    __syncthreads();
    XcdBarrier xbar; xbar.bar = (unsigned*)(args.ws + WS_CTL + 4096); xbar.x = 0; xbar.st = bst;
#define GSYNC() xcd_barrier(xbar)
#define tid TID_O()
#define lane (TID_O() & 63)
#define wave __builtin_amdgcn_readfirstlane(TID_O() >> 6)
#define gwave (bx * 8 + wave)
#define nwaves (G * 8)
#define gtid (bx * 512 + TID_O())
#define gthreads (G * 512)
    unsigned char* ws = args.ws;
    float* OUT = args.out;

#pragma unroll 1
    for (int st = 0; st < 12; ++st) {
        const int l = st / 3, ph = st - 3 * l;
        if (st == 0) {
            const int lane_o = lane; const int gw_o = gwave;
            convert_weights(args, ws, 3, 0, gw_o, nwaves, (LAS float*)(lds + wave * 16384), lane_o);
            if (bx == 0 && TID_O() < 2) ((unsigned*)(opq(ws) + WS_CTL))[64 * TID_O()] = 0u;
                for (int m = gw_o; m < T; m += 2 * nwaves) {
                    const int m2 = m + nwaves; const bool two = m2 < T;
                    const f32x4* xr = (const f32x4*)(inp(args, 0) + (size_t)m * D) + lane_o; const f32x4* xr2 = (const f32x4*)(inp(args, 0) + (size_t)(two ? m2 : m) * D) + lane_o;
                    f32x4 v[4], v2[4];
#pragma unroll
                    for (int j = 0; j < 4; ++j) { v[j] = xr[64 * j]; v2[j] = xr2[64 * j]; }
                    float s = 0.f, s2 = 0.f;
                    unsigned long long* o8 = (unsigned long long*)(XB + (size_t)m * D) + lane_o; unsigned long long* o82 = (unsigned long long*)(XB + (size_t)(two ? m2 : m) * D) + lane_o;
#pragma unroll
                    for (int j = 0; j < 4; ++j) { s += (v[j][0] * v[j][0] + v[j][1] * v[j][1]) + (v[j][2] * v[j][2] + v[j][3] * v[j][3]); s2 += (v2[j][0] * v2[j][0] + v2[j][1] * v2[j][1]) + (v2[j][2] * v2[j][2] + v2[j][3] * v2[j][3]);
                        o8[64 * j] = (unsigned long long)pk2(v[j][0], v[j][1]) | ((unsigned long long)pk2(v[j][2], v[j][3]) << 32);
                        if (two) o82[64 * j] = (unsigned long long)pk2(v2[j][0], v2[j][1]) | ((unsigned long long)pk2(v2[j][2], v2[j][3]) << 32); }
                    s = wave_sum(s); s2 = wave_sum(s2);
                    if (lane_o < 16) { STAT[(size_t)m * 16 + lane_o] = (lane_o == 0) ? s : 0.f; if (two) STAT[(size_t)m2 * 16 + lane_o] = (lane_o == 0) ? s2 : 0.f; } }
            grid.sync(); xbar = xcd_barrier_post((unsigned*)(args.ws + WS_CTL + 4096), bst);
        }
        if (ph != 1) {
            bfu* H = ACT;
            for (int rep = 0; rep < REP_FFI; ++rep)
            { pg8::Gemm g{XB, ph == 0 ? W1IN : W2IN, T, 2 * FF, D}; pg8::StaticOrder S; S.init(T, 2 * FF, G, bx);
              pg8::rstd_table(lds, STAT, S, TID_O());
              pg8::EpiSwiGLU E{H, (const LAS float*)(lds + pg8::RSTD_OFF)};
              pg8::gemm_phase<pg8::EpiSwiGLU, pg8::StaticOrder, GEMM_ALIGN, GEMM_SP2>(lds, g, S, E);
              if (ph == 0 || l < 3) { const int nwg = (T / 256) * (2 * FF / 256), rounds = (nwg + G - 1) / G, nlast = nwg - (rounds - 1) * G;
                  const int grp = (ph == 0) ? 4 : 3, lay = (ph == 0) ? l : l + 1;
                  if (nlast == G) convert_weights(args, ws, grp, lay, gwave, nwaves, (LAS float*)(lds + wave * 16384), lane);
                  else if (bx >= nlast) convert_weights(args, ws, grp, lay, (bx - nlast) * 8 + wave, (G - nlast) * 8, (LAS float*)(lds + wave * 16384), lane); } }
            GSYNC();
            { pg8::Gemm g{H, ph == 0 ? W1OUT : W2OUT, T, D, FF}; pg8::StaticOrder S; S.init(T, D, G, bx);
              pg8::EpiRes E{OUT, XB, STAT, 0.5f, st == 11 ? 1 : 0};
              pg8::gemm_phase<pg8::EpiRes, pg8::StaticOrder, GEMM_ALIGN, GEMM_SP2>(lds, g, S, E); }
            GSYNC();
        } else {
            const bfu* A2 = ACT; int KMO = 1024;
#ifndef DIS_MIX
            if (l == 0) {
                bfu* Qb = ACT; bfu* Kb = ACT + (size_t)T * 1024; bfu* Vb = ACT + (size_t)2 * T * 1024; bfu* O0 = ACT + (size_t)3 * T * 1024; bfu* O1 = ACT + (size_t)4 * T * 1024;
                { pg8::Gemm g{XB, WMIN, T, 3072, D}; pg8::StaticOrder S; S.init(T, 3072, G, bx);
                  pg8::rstd_table(lds, STAT, S, TID_O());
                  pg8::EpiRoute<0> E{Qb, Kb, Vb, nullptr, (const LAS float*)(lds + pg8::RSTD_OFF), nullptr, inp(args, 9), inp(args, 10)};
                  pg8::gemm_phase<pg8::EpiRoute<0>, pg8::StaticOrder, GEMM_ALIGN, GEMM_SP2>(lds, g, S, E); }
                GSYNC();
#ifndef DIS_ATTN
                {
                    int ln = lane; asm volatile("" : "+v"(ln));
                    float gq = fabsf(inp(args, 9)[ln]), gk = fabsf(inp(args, 10)[ln]);
#pragma unroll
                    for (int o = 1; o < 64; o <<= 1) { const int src = (ln ^ o) << 2;
                        gq = fmaxf(gq, __int_as_float(__builtin_amdgcn_ds_bpermute(src, __float_as_int(gq)))); gk = fmaxf(gk, __int_as_float(__builtin_amdgcn_ds_bpermute(src, __float_as_int(gk)))); }
                    const float bound = __int_as_float(__builtin_amdgcn_readfirstlane(__float_as_int(16.0f * gq * gk + 30.0f)));
                    volatile LAS unsigned* sU = (volatile LAS unsigned*)(lds + 140 * 1024);
                    for (int rep = 0; rep < REP_ATT; ++rep) {
                    unsigned* qctr = (unsigned*)(opq(ws) + WS_CTL) + 64 * rep;
                    for (;;) {
                        if (TID_O() == 0) sU[0] = atomicAdd(qctr, 1u);
                        __syncthreads();
                        const int u = (int)sU[0];
                        __syncthreads();
                        if (u >= 1024) break;
                        const int hh = 7 - (u >> 7), r = u & 127, qb = 63 - (r >> 1), mm = r & 1, hm = hh * 2 + mm;
                        const float slope = exp2f(-(float)(hh + 1)); const float sl2 = slope * LOG2E;
                        const int ks = qb * 256 - (int)ceilf(bound / slope); const int t0 = ks <= 0 ? 0 : ((ks >> 6) & ~1);
                        attn_body::attn_unit<8>(qb, t0, sl2, (const attn_body::bf16*)(Qb + hm * 64), (const attn_body::bf16*)(Kb + hm * 64), (const attn_body::bf16*)(Vb + hh * 128),
                                                (attn_body::bf16*)((mm ? O1 : O0) + hh * 128), (char*)lds_raw);
                    }
                    }
                }
#endif
                GSYNC();
                da_combine(O0, O1, inp(args, 11), gwave, nwaves, lane);
                A2 = O0; KMO = 1024;
            } else if (l == 1) {
                bfu* Qb = ACT; bfu* Kb = ACT + (size_t)T * 1024; bfu* Vb = ACT + (size_t)2 * T * 1024; bfu* Gb = ACT + (size_t)4 * T * 1024;
                { pg8::Gemm g{XB, WMIN, T, 6144, D}; pg8::StaticOrder S; S.init(T, 6144, G, bx);
                  pg8::rstd_table(lds, STAT, S, TID_O());
                  pg8::EpiRoute<1> E{Qb, Kb, Vb, Gb, (const LAS float*)(lds + pg8::RSTD_OFF), nullptr, nullptr, nullptr};
                  pg8::gemm_phase<pg8::EpiRoute<1>, pg8::StaticOrder, GEMM_ALIGN, GEMM_SP2>(lds, g, S, E); }
                GSYNC();
#ifndef DIS_RT
                rt_state_phase(lds, bx, G, Kb, Vb, SR, tid);
                GSYNC();
                rt_scan(SR, gtid, gthreads);
                GSYNC();
                for (int u = bx; u < 512; u += G) rt_chunk_unit(lds, u, Qb, Kb, Vb, Vb, Gb, SR, tid);
#endif
                A2 = Vb; KMO = 2048;
            } else if (l == 2) {
                bfu* Ub = ACT; bfu* Vb = ACT + (size_t)T * 3072;
                { pg8::Gemm g{XB, WMIN, T, 6144, D}; pg8::StaticOrder S; S.init(T, 6144, G, bx);
                  pg8::rstd_table(lds, STAT, S, TID_O());
                  pg8::EpiRoute<2> E{Ub, Vb, nullptr, nullptr, (const LAS float*)(lds + pg8::RSTD_OFF), SGSTAT, nullptr, nullptr};
                  pg8::gemm_phase<pg8::EpiRoute<2>, pg8::StaticOrder, GEMM_ALIGN, GEMM_SP2>(lds, g, S, E); }
                GSYNC();
#ifndef DIS_SG
#if REP_SG > 1
                for (int u = bx; u < 1024; u += G) sg_unit(lds, u, Ub, SR, Vb, SGSTAT, inp(args, 19), inp(args, 20), inp(args, 18), tid);
#endif
                for (int u = bx; u < 1024; u += G) sg_unit(lds, u, Ub, Ub, Vb, SGSTAT, inp(args, 19), inp(args, 20), inp(args, 18), tid);
#endif
                A2 = Ub; KMO = 3072;
            } else {
                bfu* P = ACT; bfu* A2w = ACT + (size_t)T * 3072;
                { pg8::Gemm g{XB, WMIN, T, 3072, D}; pg8::StaticOrder S; S.init(T, 3072, G, bx);
                  pg8::rstd_table(lds, STAT, S, TID_O());
                  pg8::EpiRoute<3> E{P, nullptr, nullptr, nullptr, (const LAS float*)(lds + pg8::RSTD_OFF), nullptr, nullptr, nullptr};
                  pg8::gemm_phase<pg8::EpiRoute<3>, pg8::StaticOrder, GEMM_ALIGN, GEMM_SP2>(lds, g, S, E); }
                GSYNC();
#ifndef DIS_LR
                for (int u = bx; u < 768; u += G) lr_unit<1>(lds, u, P, WAX, inp(args, 23), inp(args, 24), inp(args, 26), inp(args, 28), inp(args, 29), LRAGG, A2w, SR, SR + (size_t)T * 1536, tid);
                GSYNC();
                for (int u = bx; u < 768; u += G) lr_stream_unit(lds, u, P, SR, SR + (size_t)T * 1536, LRAGG, A2w, tid);
#endif
                A2 = A2w; KMO = 1536;
            }
#endif
            GSYNC();
            { pg8::Gemm g{A2, WMOUT, T, D, KMO}; pg8::StaticOrder S; S.init(T, D, G, bx);
              pg8::EpiRes E{OUT, XB, STAT, 1.0f, 0};
              pg8::gemm_phase<pg8::EpiRes, pg8::StaticOrder, GEMM_ALIGN, GEMM_SP2>(lds, g, S, E); }
            GSYNC();
        }
    }
}

#undef tid
#undef lane
#undef wave
#undef gwave
#undef nwaves
#undef gtid
#undef gthreads
extern "C" void kernel_launch(void* const* d_in, const int* in_sizes, int n_in, void* d_out, int out_size, void* d_ws, size_t ws_size, hipStream_t stream) {
    static int grid = 0;
    if (grid == 0) {
        if (n_in != 31 || out_size != T * D || ws_size < WS_END) { fprintf(stderr, "kernel_launch: unexpected shapes (n_in %d out %d ws %zu need %zu)\n", n_in, out_size, ws_size, (size_t)WS_END); grid = -1; return; }
        int dev = 0, cus = 0, per_cu = 0;
        (void)hipGetDevice(&dev);
        (void)hipDeviceGetAttribute(&cus, hipDeviceAttributeMultiprocessorCount, dev);
        (void)hipFuncSetAttribute((const void*)mk_fwd, hipFuncAttributeMaxDynamicSharedMemorySize, LDS_BYTES);
        (void)hipOccupancyMaxActiveBlocksPerMultiprocessor(&per_cu, (const void*)mk_fwd, 512, LDS_BYTES);
        (void)hipGetLastError();
        grid = cus;
        fprintf(stderr, "kernel_launch: grid %d (occupancy query %d per CU), ws %zu\n", grid, per_cu, ws_size);
    }
    if (grid < 0) return;
    Args a{};
    for (int i = 0; i < 31; ++i) a.in[i] = (const float*)d_in[i];
    a.out = (float*)d_out; a.ws = (unsigned char*)d_ws;
    void* kargs[] = {&a};
    hipError_t e = hipLaunchCooperativeKernel((void*)mk_fwd, dim3(grid), dim3(512), kargs, LDS_BYTES, stream);
    if (e != hipSuccess) fprintf(stderr, "kernel_launch: cooperative launch failed: %s (grid %d)\n", hipGetErrorString(e), grid);
}
```
